# Optimizing an MI355X kernel written in HIP

```python
import math
import jax, jax.numpy as jnp
from jax import lax
import numpy as np

D_MODEL = 1024
BATCH = 4
SEQ = 8192
DEPTH = 1

ATT_HEADS = 8
ATT_QK_DIM = 64
ATT_V_DIM = 2 * ATT_QK_DIM
ATT_QK_WIDTH = ATT_HEADS * 2 * ATT_QK_DIM
ATT_V_WIDTH = ATT_HEADS * ATT_V_DIM
REC_HEADS = 8
REC_K_DIM = 128
REC_V_DIM = 128
REC_F_WIDTH = REC_HEADS * REC_K_DIM
REC_V_WIDTH = REC_HEADS * REC_V_DIM
REC_CHUNK = 64
D_FF = 4 * D_MODEL
ROPE_THETA = 500000.0
ROPE_DIM = ATT_QK_DIM // 4
Q_BLOCK = 128
EPS = 1e-6
N_ADA = 6
IN_WIDTHS = (ATT_QK_WIDTH, ATT_QK_WIDTH, ATT_V_WIDTH,
             REC_F_WIDTH, REC_F_WIDTH, REC_V_WIDTH, REC_V_WIDTH,
             D_MODEL, D_MODEL)
IN_WIDTH = sum(IN_WIDTHS)

kernel_name = "hybrid_diffattn_hgrn2_gated_merge"


def rmsnorm(x, w):
    xf = x.astype(jnp.float32)
    y = xf * lax.rsqrt(jnp.mean(xf * xf, axis=-1, keepdims=True) + EPS)
    return (y * w.astype(jnp.float32)).astype(x.dtype)


def lambda_init_fn(layer_idx):
    return 0.8 - 0.6 * math.exp(-0.3 * layer_idx)


def rope_partial(t, cos, sin):
    half = ROPE_DIM // 2
    t1, t2, rest = t[..., :half], t[..., half:ROPE_DIM], t[..., ROPE_DIM:]
    cos = cos.astype(t.dtype)
    sin = sin.astype(t.dtype)
    return jnp.concatenate([t1 * cos - t2 * sin, t2 * cos + t1 * sin, rest], axis=-1)


def diff_attention(q, k, v, lam):
    B, S = q.shape[0], q.shape[1]
    nb = S // Q_BLOCK
    qb = q.reshape(B, nb, Q_BLOCK, ATT_HEADS, 2, ATT_QK_DIM).transpose(1, 0, 2, 3, 4, 5)
    key_idx = jnp.arange(S)
    scale = ATT_QK_DIM ** -0.5

    def block(args):
        qi, i = args
        s = jnp.einsum('bqhmd,bkhmd->bhmqk', qi, k).astype(jnp.float32) * scale
        q_idx = i * Q_BLOCK + jnp.arange(Q_BLOCK)
        mask = key_idx[None, :] <= q_idx[:, None]
        p = jax.nn.softmax(jnp.where(mask, s, -jnp.inf), axis=-1)
        a = (p[:, :, 0] - lam * p[:, :, 1]).astype(v.dtype)
        return jnp.einsum('bhqk,bkhe->bqhe', a, v)

    o = lax.map(block, (qb, jnp.arange(nb)))
    return o.transpose(1, 0, 2, 3, 4).reshape(B, S, ATT_HEADS, ATT_V_DIM)


def hgrn2_chunkwise(q, k, v, log_f):
    B, S = q.shape[0], q.shape[1]
    nc = S // REC_CHUNK

    def to_chunks(t):
        return t.astype(jnp.float32).reshape(B, nc, REC_CHUNK, REC_HEADS, t.shape[-1]).transpose(1, 0, 3, 2, 4)

    causal = jnp.tril(jnp.ones((REC_CHUNK, REC_CHUNK), dtype=bool))

    def step(state, inp):
        qc, kc, vc, gc = inp
        b = jnp.cumsum(gc, axis=2)
        rel = jnp.where(causal[:, :, None], b[:, :, :, None, :] - b[:, :, None, :, :], -jnp.inf)
        scores = jnp.einsum('bhtk,bhsk,bhtsk->bhts', qc, kc, jnp.exp(rel))
        o = (jnp.einsum('bhts,bhsv->bhtv', scores, vc)
             + jnp.einsum('bhtk,bhkv->bhtv', qc * jnp.exp(b), state))
        b_last = b[:, :, -1:, :]
        state = (jnp.exp(b_last[:, :, 0, :, None]) * state
                 + jnp.einsum('bhsk,bhsv->bhkv', kc * jnp.exp(b_last - b), vc))
        return state, o

    s0 = jnp.zeros((B, REC_HEADS, REC_K_DIM, REC_V_DIM), jnp.float32)
    _, o = lax.scan(step, s0, (to_chunks(q), to_chunks(k), to_chunks(v), to_chunks(log_f)))
    return o.transpose(1, 0, 3, 2, 4).reshape(B, S, REC_HEADS, REC_V_DIM)


def setup_inputs(seed: int = 0) -> dict:
    key = jax.random.key(seed)
    ks = jax.random.split(key, 24)
    nrm = jax.random.normal
    f32 = jnp.float32

    def gain(k, shape):
        return 1.0 + 0.02 * nrm(k, shape, f32)

    offsets = jax.random.randint(ks[2], (BATCH, 1), 0, 4096, dtype=jnp.int32)
    positions = offsets + jnp.arange(SEQ, dtype=jnp.int32)[None, :]
    return {
        "x": nrm(ks[0], (BATCH, SEQ, D_MODEL), f32),
        "c": nrm(ks[1], (BATCH, D_MODEL), f32),
        "positions": positions,
        "w_ada": nrm(ks[3], (DEPTH, D_MODEL, N_ADA * D_MODEL), f32) * D_MODEL ** -0.5,
        "b_ada": 0.02 * nrm(ks[4], (DEPTH, N_ADA * D_MODEL), f32),
        "norm_mix": gain(ks[5], (DEPTH, D_MODEL)),
        "w_in": nrm(ks[6], (DEPTH, D_MODEL, IN_WIDTH), f32) * D_MODEL ** -0.5,
        "lam_q1": 0.1 * nrm(ks[7], (DEPTH, ATT_QK_DIM), f32),
        "lam_k1": 0.1 * nrm(ks[8], (DEPTH, ATT_QK_DIM), f32),
        "lam_q2": 0.1 * nrm(ks[9], (DEPTH, ATT_QK_DIM), f32),
        "lam_k2": 0.1 * nrm(ks[10], (DEPTH, ATT_QK_DIM), f32),
        "subln_w": gain(ks[11], (DEPTH, ATT_V_DIM)),
        "lb_logits": 0.5 * nrm(ks[12], (DEPTH + 1, REC_F_WIDTH), f32),
        "rec_norm_w": gain(ks[13], (DEPTH, REC_V_DIM)),
        "w_proj_att": nrm(ks[14], (DEPTH, ATT_V_WIDTH, D_MODEL), f32) * ATT_V_WIDTH ** -0.5,
        "w_proj_rec": nrm(ks[15], (DEPTH, REC_V_WIDTH, D_MODEL), f32) * REC_V_WIDTH ** -0.5,
        "w_out": nrm(ks[16], (DEPTH, D_MODEL, D_MODEL), f32) * D_MODEL ** -0.5,
        "norm_mlp": gain(ks[17], (DEPTH, D_MODEL)),
        "w_mlp_in": nrm(ks[18], (DEPTH, D_MODEL, D_FF), f32) * D_MODEL ** -0.5,
        "w_mlp_out": nrm(ks[19], (DEPTH, D_FF, D_MODEL), f32) * D_FF ** -0.5,
        "norm_final": gain(ks[20], (D_MODEL,)),
    }


def reference(x, c, positions, w_ada, b_ada, norm_mix, w_in, lam_q1, lam_k1, lam_q2, lam_k2,
              subln_w, lb_logits, rec_norm_w, w_proj_att, w_proj_rec, w_out, norm_mlp,
              w_mlp_in, w_mlp_out, norm_final):
    B, S, _ = x.shape
    f32 = jnp.float32
    split_points = np.cumsum(IN_WIDTHS)[:-1].tolist()

    inv_freq = ROPE_THETA ** (-jnp.arange(0, ROPE_DIM, 2, dtype=f32) / ROPE_DIM)
    ang = positions.astype(f32)[..., None] * inv_freq
    cos = jnp.cos(ang)[:, :, None, None, :]
    sin = jnp.sin(ang)[:, :, None, None, :]

    lb_p = jax.nn.softmax(lb_logits.astype(f32), axis=0)
    lb_cum = jnp.cumsum(lb_p, axis=0) - lb_p[0]

    cond = jax.nn.silu(c)
    for l in range(DEPTH):
        ada = cond @ w_ada[l] + b_ada[l]
        sh_m, sc_m, g_m, sh_f, sc_f, g_f = [a[:, None, :] for a in jnp.split(ada, N_ADA, axis=-1)]

        h = rmsnorm(x, norm_mix[l]) * (1.0 + sc_m) + sh_m
        proj = h @ w_in[l]
        q, k, v, rq, rf, ri, rg, ga, gr = jnp.split(proj, split_points, axis=-1)

        lam_init = lambda_init_fn(l)
        lam = (jnp.exp(jnp.sum(lam_q1[l].astype(f32) * lam_k1[l].astype(f32)))
               - jnp.exp(jnp.sum(lam_q2[l].astype(f32) * lam_k2[l].astype(f32))) + lam_init)
        qa = rope_partial(q.reshape(B, S, ATT_HEADS, 2, ATT_QK_DIM), cos, sin)
        ka = rope_partial(k.reshape(B, S, ATT_HEADS, 2, ATT_QK_DIM), cos, sin)
        va = v.reshape(B, S, ATT_HEADS, ATT_V_DIM)
        o_a = diff_attention(qa, ka, va, lam)
        o_a = (rmsnorm(o_a, subln_w[l]) * (1.0 - lam_init)).reshape(B, S, ATT_V_WIDTH)

        lb = lb_cum[l + 1]
        f = lb + (1.0 - lb) * jax.nn.sigmoid(rf.astype(f32))
        heads_k = lambda t: t.reshape(B, S, REC_HEADS, REC_K_DIM)
        o_r = hgrn2_chunkwise(heads_k(rq), heads_k(1.0 - f), ri.reshape(B, S, REC_HEADS, REC_V_DIM),
                              heads_k(jnp.log(f)))
        o_r = o_r.astype(x.dtype)
        o_r = (rmsnorm(o_r, rec_norm_w[l]) * jax.nn.silu(rg.reshape(B, S, REC_HEADS, REC_V_DIM))
               ).reshape(B, S, REC_V_WIDTH)

        y = jax.nn.sigmoid(ga) * (o_a @ w_proj_att[l]) + jax.nn.sigmoid(gr) * (o_r @ w_proj_rec[l])
        x = x + g_m * (y @ w_out[l])

        h = rmsnorm(x, norm_mlp[l]) * (1.0 + sc_f) + sh_f
        u = jnp.square(jax.nn.relu(h @ w_mlp_in[l]))
        x = x + g_f * (u @ w_mlp_out[l])

    return rmsnorm(x, norm_final)
```

```cpp
#include <hip/hip_runtime.h>
#include <hip/hip_cooperative_groups.h>
#include <cstdio>
#include <cstdint>
namespace cg = cooperative_groups;
__device__ __forceinline__ int fresh_tid() { int t = threadIdx.x; asm volatile("" : "+v"(t)); return t; }
namespace pg8 {
#define PG8_LAS __attribute__((address_space(3)))
typedef unsigned short bf16_t;
typedef short bf16x8 __attribute__((ext_vector_type(8)));
typedef float f32x4 __attribute__((ext_vector_type(4)));
typedef unsigned u32x4 __attribute__((ext_vector_type(4)));
constexpr int BM = 256, BK = 64, HALF = 128, HTB = HALF * BK * 2  , STAGE_BYTES = 8 * HTB, NXCD = 8, WGM = 8;

__host__ __device__ __forceinline__ int lds_byte(int r, int c) { const int st = (r >> 4) * 2 + (c >> 5), rr = r & 15, cc = c & 31, ob = rr * 64 + cc * 2; return st * 1024 + (ob ^ (((ob >> 9) & 1) << 5)); }
__host__ __device__ __forceinline__ void stage_rc(int b, int& R, int& C) { const int st = b / 1024, sb = b % 1024, swz = sb ^ (((sb >> 9) & 1) << 5); R = (st >> 1) * 16 + swz / 64; C = (st & 1) * 32 + (swz % 64) / 2; }
__host__ __device__ __forceinline__ int perm32(int rho) { const int n = rho >> 4, i = rho & 15; return 8 * (i >> 2) + 4 * n + (i & 3); }

struct Unit { int pm, pn; };
struct Gemm { const bf16_t* A; const bf16_t* Bt; int M, N, K; };

struct StaticOrder {
    int nM, nN, nwg, G, c;
    __host__ __device__ void init(int M, int N, int G_, int c_) { nM = M / BM; nN = N / BM; nwg = nM * nN; G = G_; c = c_; }
    __host__ __device__ bool next(int i, Unit& u) const {
        const long L = (long)i * G + c; if (L >= nwg) return false;
        int wgid = (int)L; { const int q = nwg / NXCD, r = nwg % NXCD, xcd = wgid % NXCD, off = wgid / NXCD; wgid = (xcd < r ? xcd * (q + 1) : r * (q + 1) + (xcd - r) * q) + off; }
        const int nig = WGM * nN, gid = wgid / nig, fm = gid * WGM, gsz = (nM - fm) < WGM ? (nM - fm) : WGM;
        u.pm = fm + ((wgid % nig) % gsz); u.pn = (wgid % nig) / gsz; return true;
    }
    __device__ __forceinline__ void a_ready(const Unit&) const {}
    __device__ __forceinline__ void done(const Unit&) const {}
};

__device__ __forceinline__ unsigned cvt_pk_bf16(float lo, float hi) { unsigned r; asm volatile("v_cvt_pk_bf16_f32 %0, %1, %2" : "=v"(r) : "v"(lo), "v"(hi)); return r; }
__device__ __forceinline__ float bf_lo(unsigned w) { return __uint_as_float(w << 16); }
__device__ __forceinline__ float bf_hi(unsigned w) { return __uint_as_float(w & 0xffff0000u); }
__device__ __forceinline__ float sigmoidf_(float x) { return __builtin_amdgcn_rcpf(1.0f + __expf(-x)); }
constexpr int TH_ROWS = 16384;
constexpr float QSCALE = 0.125f * 1.4426950408889634f;

struct EpiInProj {
    static constexpr bool PERM = true, AFTER_DRAIN = false;
    bf16_t* P; const float* rope;
    __device__ __forceinline__ void operator()(const f32x4 (&acc)[2][2][4][2], const Unit& u, int wr, int wc, int fr, int fq) const {
        const int t = u.pn >> 2, colt = (u.pn & 3) * 256;
        bf16_t* base = P + (size_t)t * TH_ROWS * 1024;
        const int row0 = u.pm * BM + wr * 64 + fr, col0 = colt + wc * 32 + 8 * fq;
        const bool isrope = (t < 2) && ((wc & 1) == 0);
        const float sc = (t == 0) ? QSCALE : 1.f;
        const float sgn = (fq == 0) ? -1.f : ((fq == 1) ? 1.f : 0.f);
#pragma unroll
        for (int ai = 0; ai < 2; ++ai)
#pragma unroll
            for (int m = 0; m < 4; ++m) {
                const int row = row0 + ai * HALF + m * 16;
                f32x4 c0 = {1.f, 1.f, 1.f, 1.f}, c1 = c0, s0 = {0.f, 0.f, 0.f, 0.f}, s1 = s0;
                if (isrope) { const f32x4* rp = (const f32x4*)(rope + (size_t)row * 16); f32x4 a = rp[0], b = rp[1], c = rp[2], d = rp[3];
                    if (fq < 2) { c0 = a; c1 = b; } s0 = c * sgn; s1 = d * sgn; }
                bf16_t* rowp = base + (size_t)row * 1024 + col0;
#pragma unroll
                for (int bj = 0; bj < 2; ++bj) {
                    f32x4 v0 = acc[ai][bj][m][0], v1 = acc[ai][bj][m][1];
                    if (isrope) {
                        f32x4 p0, p1;
#pragma unroll
                        for (int j = 0; j < 4; ++j) { p0[j] = __shfl_xor(v0[j], 16); p1[j] = __shfl_xor(v1[j], 16); }
                        v0 = v0 * c0 + p0 * s0; v1 = v1 * c1 + p1 * s1;
                    }
                    v0 = v0 * sc; v1 = v1 * sc;
                    u32x4 w; w.x = cvt_pk_bf16(v0[0], v0[1]); w.y = cvt_pk_bf16(v0[2], v0[3]); w.z = cvt_pk_bf16(v1[0], v1[1]); w.w = cvt_pk_bf16(v1[2], v1[3]);
                    *(u32x4*)(rowp + bj * HALF) = w;
                }
            }
    }
};
struct EpiGate1 {
    static constexpr bool PERM = true, AFTER_DRAIN = false;
    const bf16_t* gate; float* Y1;
    __device__ __forceinline__ void operator()(const f32x4 (&acc)[2][2][4][2], const Unit& u, int wr, int wc, int fr, int fq) const {
        const int row0 = u.pm * BM + wr * 64 + fr, col0 = u.pn * BM + wc * 32 + 8 * fq;
#pragma unroll
        for (int ai = 0; ai < 2; ++ai)
#pragma unroll
            for (int m = 0; m < 4; ++m) {
                const size_t off = (size_t)(row0 + ai * HALF + m * 16) * 1024 + col0;
#pragma unroll
                for (int bj = 0; bj < 2; ++bj) {
                    const u32x4 g = *(const u32x4*)(gate + off + bj * HALF);
                    f32x4 v0 = acc[ai][bj][m][0], v1 = acc[ai][bj][m][1];
                    v0[0] *= sigmoidf_(bf_lo(g.x)); v0[1] *= sigmoidf_(bf_hi(g.x)); v0[2] *= sigmoidf_(bf_lo(g.y)); v0[3] *= sigmoidf_(bf_hi(g.y));
                    v1[0] *= sigmoidf_(bf_lo(g.z)); v1[1] *= sigmoidf_(bf_hi(g.z)); v1[2] *= sigmoidf_(bf_lo(g.w)); v1[3] *= sigmoidf_(bf_hi(g.w));
                    *(f32x4*)(Y1 + off + bj * HALF) = v0; *(f32x4*)(Y1 + off + bj * HALF + 4) = v1;
                }
            }
    }
};
struct EpiGate2 {
    static constexpr bool PERM = true, AFTER_DRAIN = false;
    const bf16_t* gate; const float* Y1; bf16_t* Y;
    __device__ __forceinline__ void operator()(const f32x4 (&acc)[2][2][4][2], const Unit& u, int wr, int wc, int fr, int fq) const {
        const int row0 = u.pm * BM + wr * 64 + fr, col0 = u.pn * BM + wc * 32 + 8 * fq;
#pragma unroll
        for (int ai = 0; ai < 2; ++ai)
#pragma unroll
            for (int m = 0; m < 4; ++m) {
                const size_t off = (size_t)(row0 + ai * HALF + m * 16) * 1024 + col0;
#pragma unroll
                for (int bj = 0; bj < 2; ++bj) {
                    const u32x4 g = *(const u32x4*)(gate + off + bj * HALF);
                    const f32x4 y0 = *(const f32x4*)(Y1 + off + bj * HALF), y1 = *(const f32x4*)(Y1 + off + bj * HALF + 4);
                    f32x4 v0 = acc[ai][bj][m][0], v1 = acc[ai][bj][m][1];
                    v0[0] = y0[0] + v0[0] * sigmoidf_(bf_lo(g.x)); v0[1] = y0[1] + v0[1] * sigmoidf_(bf_hi(g.x)); v0[2] = y0[2] + v0[2] * sigmoidf_(bf_lo(g.y)); v0[3] = y0[3] + v0[3] * sigmoidf_(bf_hi(g.y));
                    v1[0] = y1[0] + v1[0] * sigmoidf_(bf_lo(g.z)); v1[1] = y1[1] + v1[1] * sigmoidf_(bf_hi(g.z)); v1[2] = y1[2] + v1[2] * sigmoidf_(bf_lo(g.w)); v1[3] = y1[3] + v1[3] * sigmoidf_(bf_hi(g.w));
                    u32x4 w; w.x = cvt_pk_bf16(v0[0], v0[1]); w.y = cvt_pk_bf16(v0[2], v0[3]); w.z = cvt_pk_bf16(v1[0], v1[1]); w.w = cvt_pk_bf16(v1[2], v1[3]);
                    *(u32x4*)(Y + off + bj * HALF) = w;
                }
            }
    }
};
struct EpiRes {
    static constexpr bool PERM = false, AFTER_DRAIN = false;
    const float* base; float* out; const float* gate;
    __device__ __forceinline__ void operator()(const f32x4 (&acc)[2][2][4][2], const Unit& u, int wr, int wc, int fr, int fq) const {
        const int row0 = u.pm * BM + wr * 64 + fr, col0 = u.pn * BM + wc * 32 + 4 * fq;
        const float* gp = gate + (size_t)((u.pm * BM) >> 13) * 6144 + col0;
        f32x4 gv[2][2];
#pragma unroll
        for (int bj = 0; bj < 2; ++bj)
#pragma unroll
            for (int n = 0; n < 2; ++n) gv[bj][n] = *(const f32x4*)(gp + bj * HALF + n * 16);
#pragma unroll
        for (int ai = 0; ai < 2; ++ai)
#pragma unroll
            for (int m = 0; m < 4; ++m) {
                const size_t off = (size_t)(row0 + ai * HALF + m * 16) * 1024 + col0;
#pragma unroll
                for (int bj = 0; bj < 2; ++bj)
#pragma unroll
                    for (int n = 0; n < 2; ++n) { const f32x4 bs = *(const f32x4*)(base + off + bj * HALF + n * 16);
                        *(f32x4*)(out + off + bj * HALF + n * 16) = bs + gv[bj][n] * acc[ai][bj][m][n]; }
            }
    }
};
struct EpiRelu2 {
    static constexpr bool PERM = true, AFTER_DRAIN = false;
    bf16_t* O; int ldc;
    __device__ __forceinline__ void operator()(const f32x4 (&acc)[2][2][4][2], const Unit& u, int wr, int wc, int fr, int fq) const {
        const int row0 = u.pm * BM + wr * 64 + fr, col0 = u.pn * BM + wc * 32 + 8 * fq;
#pragma unroll
        for (int ai = 0; ai < 2; ++ai)
#pragma unroll
            for (int m = 0; m < 4; ++m) {
                bf16_t* rowp = O + (size_t)(row0 + ai * HALF + m * 16) * ldc + col0;
#pragma unroll
                for (int bj = 0; bj < 2; ++bj) {
                    f32x4 v0 = acc[ai][bj][m][0], v1 = acc[ai][bj][m][1];
#pragma unroll
                    for (int j = 0; j < 4; ++j) { const float a = fmaxf(v0[j], 0.f), b = fmaxf(v1[j], 0.f); v0[j] = a * a; v1[j] = b * b; }
                    u32x4 w; w.x = cvt_pk_bf16(v0[0], v0[1]); w.y = cvt_pk_bf16(v0[2], v0[3]); w.z = cvt_pk_bf16(v1[0], v1[1]); w.w = cvt_pk_bf16(v1[2], v1[3]);
                    *(u32x4*)(rowp + bj * HALF) = w;
                }
            }
    }
};
template <class Epi, class Sched, bool ALIGN_EPI = false, bool SP2 = false>
__device__ __forceinline__ void gemm_phase(PG8_LAS unsigned char* lds, const Gemm g, const Sched& S, const Epi& E) {
    const int tid = fresh_tid(), wid = __builtin_amdgcn_readfirstlane(tid >> 6), lane = tid & 63, wr = wid >> 2, wc = wid & 3, fr = lane & 15, fq = lane >> 4;
    const int K = g.K, nt = K / BK;
    unsigned voffA[2], voffB[2];
#pragma unroll
    for (int i = 0; i < 2; ++i) { int R, C; stage_rc(tid * 16 + i * 8192, R, C); const int Rb = Epi::PERM ? ((R & ~31) + perm32(R & 31)) : R;
        voffA[i] = (unsigned)(R * K + C) * 2u; voffB[i] = (unsigned)(Rb * K + C) * 2u; }
    const size_t kstep = (size_t)(BK * 2);
    const size_t hstep = (size_t)HALF * K * 2;
    const size_t tstep = 2 * hstep;
    const unsigned ldsw = (unsigned)wid * 1024u;
    const int aoff = lds_byte(wr * 64 + fr, fq * 8), boff = lds_byte(wc * 32 + fr, fq * 8);
#define PG8_SA(b, h) (((b) * 2 + (h)) * HTB)
#define PG8_SB(b, h) ((4 + (b) * 2 + (h)) * HTB)
#define PG8_STAGE(bufoff, gbase, voff) do { _Pragma("unroll") for (int _i = 0; _i < 2; ++_i) \
        __builtin_amdgcn_global_load_lds((const unsigned*)((const char*)(gbase) + (voff)[_i]), (PG8_LAS unsigned*)(lds + (bufoff) + ldsw + _i * 8192), 16, 0, 0); } while (0)
#define PG8_LDA(dst, b, h) do { _Pragma("unroll") for (int m = 0; m < 4; ++m) _Pragma("unroll") for (int k = 0; k < 2; ++k) dst[m][k] = *(const PG8_LAS bf16x8*)(lds + PG8_SA(b, h) + aoff + m * 2048 + k * 1024); } while (0)
#define PG8_LDB(dst, b, h) do { _Pragma("unroll") for (int n = 0; n < 2; ++n) _Pragma("unroll") for (int k = 0; k < 2; ++k) dst[n][k] = *(const PG8_LAS bf16x8*)(lds + PG8_SB(b, h) + boff + n * 2048 + k * 1024); } while (0)
#define PG8_MMA(ai, bj, At, Bt) do { __builtin_amdgcn_s_setprio(1); _Pragma("unroll") for (int m = 0; m < 4; ++m) _Pragma("unroll") for (int n = 0; n < 2; ++n) _Pragma("unroll") for (int k = 0; k < 2; ++k) \
        acc[ai][bj][m][n] = __builtin_amdgcn_mfma_f32_16x16x32_bf16(Bt[n][k], At[m][k], acc[ai][bj][m][n], 0, 0, 0); __builtin_amdgcn_s_setprio(0); } while (0)
#define PG8_WAIT_V(n) asm volatile("s_waitcnt vmcnt(" #n ")" ::: "memory")
#define PG8_WAIT_L(n) asm volatile("s_waitcnt lgkmcnt(" #n ")" ::: "memory")
#define PG8_BAR __builtin_amdgcn_s_barrier()
#define PG8_SCHED __builtin_amdgcn_sched_barrier(0)
    Unit cur, nxt; int ui = 0;
    if (!S.next(0, cur)) return;
    f32x4 acc[2][2][4][2];
#pragma unroll
    for (int a = 0; a < 2; ++a)
#pragma unroll
        for (int b = 0; b < 2; ++b)
#pragma unroll
            for (int m = 0; m < 4; ++m)
#pragma unroll
                for (int n = 0; n < 2; ++n) acc[a][b][m][n] = (f32x4){0.f, 0.f, 0.f, 0.f};
    bf16x8 At[4][2], B0[2][2], B1[2][2];
    const char* cA = (const char*)g.A + (size_t)cur.pm * tstep; const char* cB = (const char*)g.Bt + (size_t)cur.pn * tstep;
    S.a_ready(cur);
    if constexpr (SP2) {
        PG8_STAGE(PG8_SB(0, 0), cB, voffB); PG8_STAGE(PG8_SB(0, 1), cB + hstep, voffB); PG8_STAGE(PG8_SA(0, 0), cA, voffA); PG8_STAGE(PG8_SA(0, 1), cA + hstep, voffA);
        if (wr == 1) PG8_BAR;
        PG8_WAIT_V(2); PG8_BAR;
        PG8_STAGE(PG8_SB(1, 0), cB + kstep, voffB); PG8_STAGE(PG8_SA(1, 0), cA + kstep, voffA); PG8_STAGE(PG8_SB(1, 1), cB + hstep + kstep, voffB);
        PG8_WAIT_V(6); PG8_BAR;
    } else {
        PG8_STAGE(PG8_SB(0, 0), cB, voffB); PG8_STAGE(PG8_SA(0, 0), cA, voffA); PG8_STAGE(PG8_SB(0, 1), cB + hstep, voffB); PG8_STAGE(PG8_SA(0, 1), cA + hstep, voffA);
        if (wr == 1) PG8_BAR;
        PG8_WAIT_V(4); PG8_BAR;
        PG8_STAGE(PG8_SB(1, 0), cB + kstep, voffB); PG8_STAGE(PG8_SA(1, 0), cA + kstep, voffA); PG8_STAGE(PG8_SB(1, 1), cB + hstep + kstep, voffB);
        PG8_WAIT_V(6); PG8_BAR;
    }
    for (;;) {
        const bool has_next = S.next(ui + 1, nxt);
        const char* nA = has_next ? (const char*)g.A + (size_t)nxt.pm * tstep : cA; const char* nB = has_next ? (const char*)g.Bt + (size_t)nxt.pn * tstep : cB;
        for (int t = 0; t < nt; t += 2) {
            const bool last = (t == nt - 2);
            const char* a1 = cA + (size_t)(t + 1) * kstep;
            const char* a2 = last ? nA : cA + (size_t)(t + 2) * kstep; const char* b2 = last ? nB : cB + (size_t)(t + 2) * kstep;
            const char* a3 = a2 + kstep; const char* b3 = b2 + kstep;
            if (last && has_next) S.a_ready(nxt);
            if constexpr (SP2) {
            PG8_LDB(B0, 0, 0); PG8_LDB(B1, 0, 1); PG8_SCHED; PG8_LDA(At, 0, 0); PG8_STAGE(PG8_SA(1, 1), a1 + hstep, voffA);
            PG8_WAIT_V(8); PG8_WAIT_L(0); PG8_BAR; PG8_MMA(0, 0, At, B0); PG8_MMA(0, 1, At, B1); PG8_BAR; PG8_SCHED;
            PG8_LDA(At, 0, 1); PG8_STAGE(PG8_SB(0, 0), b2, voffB); PG8_STAGE(PG8_SB(0, 1), b2 + hstep, voffB); PG8_STAGE(PG8_SA(0, 0), a2, voffA);
            PG8_WAIT_V(8); PG8_WAIT_L(0); PG8_BAR; PG8_MMA(1, 0, At, B0); PG8_MMA(1, 1, At, B1); PG8_BAR; PG8_SCHED;
            PG8_LDB(B0, 1, 0); PG8_LDB(B1, 1, 1); PG8_SCHED; PG8_LDA(At, 1, 0); PG8_STAGE(PG8_SA(0, 1), a2 + hstep, voffA);
            PG8_WAIT_V(8); PG8_WAIT_L(0); PG8_BAR; PG8_MMA(0, 0, At, B0); PG8_MMA(0, 1, At, B1); PG8_BAR; PG8_SCHED;
            PG8_LDA(At, 1, 1); PG8_STAGE(PG8_SB(1, 0), b3, voffB); PG8_STAGE(PG8_SB(1, 1), b3 + hstep, voffB); PG8_STAGE(PG8_SA(1, 0), a3, voffA);
            PG8_WAIT_V(8); PG8_WAIT_L(0); PG8_BAR; PG8_MMA(1, 0, At, B0); PG8_MMA(1, 1, At, B1); PG8_BAR; PG8_SCHED;
            } else {
            PG8_LDB(B0, 0, 0); PG8_SCHED; PG8_LDA(At, 0, 0); PG8_STAGE(PG8_SA(1, 1), a1 + hstep, voffA);
            PG8_WAIT_L(8); PG8_BAR; PG8_WAIT_L(0); PG8_MMA(0, 0, At, B0); PG8_BAR; PG8_SCHED;
            PG8_LDB(B1, 0, 1); PG8_STAGE(PG8_SB(0, 0), b2, voffB);
            PG8_BAR; PG8_WAIT_L(0); PG8_MMA(0, 1, At, B1); PG8_BAR;
            PG8_LDA(At, 0, 1); PG8_STAGE(PG8_SA(0, 0), a2, voffA);
            PG8_BAR; PG8_WAIT_L(0); PG8_MMA(1, 0, At, B0); PG8_BAR; PG8_SCHED;
            PG8_STAGE(PG8_SB(0, 1), b2 + hstep, voffB);
            PG8_WAIT_V(6); PG8_BAR; PG8_MMA(1, 1, At, B1); PG8_BAR;
            PG8_LDB(B0, 1, 0); PG8_SCHED; PG8_LDA(At, 1, 0); PG8_STAGE(PG8_SA(0, 1), a2 + hstep, voffA);
            PG8_WAIT_L(8); PG8_BAR; PG8_WAIT_L(0); PG8_MMA(0, 0, At, B0); PG8_BAR; PG8_SCHED;
            PG8_LDB(B1, 1, 1); PG8_STAGE(PG8_SB(1, 0), b3, voffB);
            PG8_BAR; PG8_WAIT_L(0); PG8_MMA(0, 1, At, B1); PG8_BAR;
            PG8_LDA(At, 1, 1); PG8_STAGE(PG8_SA(1, 0), a3, voffA);
            PG8_BAR; PG8_WAIT_L(0); PG8_MMA(1, 0, At, B0); PG8_BAR; PG8_SCHED;
            PG8_STAGE(PG8_SB(1, 1), b3 + hstep, voffB);
            PG8_WAIT_V(6); PG8_BAR; PG8_MMA(1, 1, At, B1); PG8_BAR;
            }
        }
        if constexpr (ALIGN_EPI) { if (wr == 0) PG8_BAR; }
        if constexpr (!Epi::AFTER_DRAIN) { E(acc, cur, wr, wc, fr, fq); S.done(cur); }
        if (!has_next) break;
#pragma unroll
        for (int a = 0; a < 2; ++a)
#pragma unroll
            for (int b = 0; b < 2; ++b)
#pragma unroll
                for (int m = 0; m < 4; ++m)
#pragma unroll
                    for (int n = 0; n < 2; ++n) acc[a][b][m][n] = (f32x4){0.f, 0.f, 0.f, 0.f};
        cur = nxt; cA = nA; cB = nB; ++ui;
        if constexpr (ALIGN_EPI) { if (wr == 1) PG8_BAR; }
    }
    PG8_WAIT_V(0);
    if constexpr (!ALIGN_EPI) { if (wr == 0) PG8_BAR; }
    PG8_BAR;
    if constexpr (Epi::AFTER_DRAIN) { E.fused(acc, cur, wr, wc, fr, fq, lds, wid, lane); S.done(cur); }
#undef PG8_SA
#undef PG8_SB
#undef PG8_STAGE
#undef PG8_LDA
#undef PG8_LDB
#undef PG8_MMA
#undef PG8_WAIT_V
#undef PG8_WAIT_L
#undef PG8_BAR
#undef PG8_SCHED
}
}
#include <hip/hip_bf16.h>
#include <cmath>
namespace attn_body {
using bf16=__hip_bfloat16;
using bf16x8=__attribute__((ext_vector_type(8)))short;
using s16x4=__attribute__((ext_vector_type(4)))short;
using f32x16=__attribute__((ext_vector_type(16)))float;
using u32x4=__attribute__((ext_vector_type(4)))unsigned;
constexpr int BATCH=2,NHEAD=16,SEQ=8192,D=64,DM=NHEAD*D;
constexpr int NW=8,QBLK=32,QB=QBLK*NW,KVBLK=64,NQB=SEQ/QB;
constexpr int ATTN_PITCH=DM, ATTN_UNIT_ROWS=QB;
__device__ __forceinline__ int crow(int r,int hi){return (r&3)+8*(r>>2)+4*hi;}
#define SBAR() __builtin_amdgcn_sched_barrier(0)
__device__ __forceinline__ void cmask(f32x16&p0,f32x16&p1,int jb,int qrel,int hi){
  const float NEG=-INFINITY; int kb=64*jb+4*hi;
  #pragma unroll
  for(int r=0;r<16;++r){int kv=kb+(r&3)+8*(r>>2); if(kv>qrel)p0[r]=NEG; if(kv+32>qrel)p1[r]=NEG;}
}

constexpr int NSLOT=3, SLOTB=8192;
constexpr int LDS_K=0, LDS_V=NSLOT*SLOTB, LDS_WS=2*NSLOT*SLOTB, LDS_OST=LDS_WS+NW*64*4, LDS_BYTES=LDS_OST+NW*4096;
constexpr float C2=0.125f*1.4426950408889634f;
__device__ __forceinline__ void glds16(const void*gsrc,unsigned lds_dst){unsigned keep;
  asm volatile("s_mov_b32 %0, m0\n\ts_mov_b32 m0, %2\n\ts_nop 0\n\tglobal_load_lds_dwordx4 %1, off\n\ts_mov_b32 m0, %0":"=&s"(keep):"v"(gsrc),"s"(lds_dst):"memory");}
__device__ __forceinline__ float max3f(float a,float b,float c){float r;asm("v_max3_f32 %0, %1, %2, %3":"=v"(r):"v"(a),"v"(b),"v"(c));return r;}
__device__ __forceinline__ float max2f(float a,float b){float r;asm("v_max_f32_e32 %0, %1, %2":"=v"(r):"v"(a),"v"(b));return r;}
__device__ __forceinline__ float fadd_s(float a,float b){float r;asm("v_add_f32_e32 %0, %1, %2":"=v"(r):"v"(a),"v"(b));return r;}
__device__ __forceinline__ float fsub_s(float a,float b){float r;asm("v_sub_f32_e32 %0, %1, %2":"=v"(r):"v"(a),"v"(b));return r;}
typedef float f32x2_t __attribute__((ext_vector_type(2))); typedef __bf16 bf16x2_t __attribute__((ext_vector_type(2)));
__device__ __forceinline__ unsigned cvtpk_s(float lo,float hi){f32x2_t v={lo,hi};bf16x2_t b=__builtin_convertvector(v,bf16x2_t);return __builtin_bit_cast(unsigned,b);}
#define WAIT_BAR(N) asm volatile("s_waitcnt vmcnt(" #N ") lgkmcnt(0)\n\ts_barrier":::"memory")

__device__ __forceinline__ void qkt(f32x16&p0,f32x16&p1,const char*Kslot,const bf16x8*qr,const f32x16&negm,int r32,int hi){
  const char*kb=Kslot+hi*1024+r32*16;
  #pragma unroll
  for(int d0=0;d0<4;++d0){
    const bf16x8 b0=*reinterpret_cast<const bf16x8*>(kb+d0*2048);
    const bf16x8 b1=*reinterpret_cast<const bf16x8*>(kb+d0*2048+512);
    if(d0==0){p0=__builtin_amdgcn_mfma_f32_32x32x16_bf16(b0,qr[0],negm,0,0,0);p1=__builtin_amdgcn_mfma_f32_32x32x16_bf16(b1,qr[0],negm,0,0,0);}
    else{p0=__builtin_amdgcn_mfma_f32_32x32x16_bf16(b0,qr[d0],p0,0,0,0);p1=__builtin_amdgcn_mfma_f32_32x32x16_bf16(b1,qr[d0],p1,0,0,0);}}
}
typedef __attribute__((address_space(3))) const char* lds_cptr;
typedef short v4i16_t __attribute__((ext_vector_type(4)));
__device__ __forceinline__ void kload8(bf16x8*kf,lds_cptr kp){
  kf[0]=*(const __attribute__((address_space(3))) bf16x8*)(kp);      kf[1]=*(const __attribute__((address_space(3))) bf16x8*)(kp+512);
  kf[2]=*(const __attribute__((address_space(3))) bf16x8*)(kp+2048); kf[3]=*(const __attribute__((address_space(3))) bf16x8*)(kp+2560);
  kf[4]=*(const __attribute__((address_space(3))) bf16x8*)(kp+4096); kf[5]=*(const __attribute__((address_space(3))) bf16x8*)(kp+4608);
  kf[6]=*(const __attribute__((address_space(3))) bf16x8*)(kp+6144); kf[7]=*(const __attribute__((address_space(3))) bf16x8*)(kp+6656);
}
__device__ __forceinline__ void kload2(bf16x8*kf,lds_cptr kp,int j){ kf[2*j]=*(const __attribute__((address_space(3))) bf16x8*)(kp+j*2048); kf[2*j+1]=*(const __attribute__((address_space(3))) bf16x8*)(kp+j*2048+512); }
__device__ __forceinline__ s16x4 vtr(lds_cptr p){ return __builtin_bit_cast(s16x4,__builtin_amdgcn_ds_read_tr16_b64_v4i16((__attribute__((address_space(3))) v4i16_t*)p)); }
__device__ __forceinline__ float rowmax(const f32x16&p0,const f32x16&p1){
  float a=max3f(p0[0],p0[1],p1[0]),b=max3f(p0[2],p0[3],p1[1]);a=max3f(a,p1[2],p1[3]);
  #pragma unroll
  for(int r=4;r<16;r+=4){a=max3f(a,p0[r],p0[r+1]);b=max3f(b,p0[r+2],p0[r+3]);a=max3f(a,p1[r],p1[r+1]);b=max3f(b,p1[r+2],p1[r+3]);}
  const float m=max2f(a,b);
  auto rr=__builtin_amdgcn_permlane32_swap(__float_as_uint(m),__float_as_uint(m),false,false);
  return max2f(__uint_as_float(rr[0]),__uint_as_float(rr[1]));
}
__device__ __forceinline__ void pv(f32x16*o,int vb,bf16x8 pa0,bf16x8 pa1,bf16x8 pa2,bf16x8 pa3){
  #pragma unroll
  for(int d0=0;d0<2;++d0){s16x4 lo[4],hi[4];
    #pragma unroll
    for(int ks=0;ks<4;++ks){
      asm volatile("ds_read_b64_tr_b16 %0,%1 offset:%c2":"=&v"(lo[ks]):"v"(vb),"i"(d0*4096+ks*1024):"memory");
      asm volatile("ds_read_b64_tr_b16 %0,%1 offset:%c2":"=&v"(hi[ks]):"v"(vb),"i"(d0*4096+ks*1024+512):"memory");}
    asm volatile("s_waitcnt lgkmcnt(0)":::"memory");SBAR();
    #define PK(k) (bf16x8){lo[k][0],lo[k][1],lo[k][2],lo[k][3],hi[k][0],hi[k][1],hi[k][2],hi[k][3]}
    o[d0]=__builtin_amdgcn_mfma_f32_32x32x16_bf16(pa0,PK(0),o[d0],0,0,0);
    o[d0]=__builtin_amdgcn_mfma_f32_32x32x16_bf16(pa1,PK(1),o[d0],0,0,0);
    o[d0]=__builtin_amdgcn_mfma_f32_32x32x16_bf16(pa2,PK(2),o[d0],0,0,0);
    o[d0]=__builtin_amdgcn_mfma_f32_32x32x16_bf16(pa3,PK(3),o[d0],0,0,0);
    #undef PK
  }
}

#ifndef ATTN_STORE16
#define ATTN_STORE16(p,v) (*(u32x4*)(p)=(v))
#endif
template<int THRL> __device__ __forceinline__ void attn_unit(int b,int h,int hv,int qb,const bf16*Q,const bf16*__restrict__ K,const bf16*__restrict__ V,bf16*O,char*shm){
  const int tid=fresh_tid(),lane=tid&63,r32=lane&31,hi=lane>>5; const int wid=__builtin_amdgcn_readfirstlane(tid>>6);
  const long rowbase=(long)b*SEQ; const int q0=qb*QB;
  const bf16*Qw=Q+(rowbase+q0+wid*QBLK)*DM+h*D;
  const bf16*Kh=K+rowbase*DM+h*D,*Vh=V+rowbase*DM+hv*D;
  const unsigned lds0=(unsigned)(uintptr_t)shm;
  float*wsf=(float*)(shm+LDS_WS)+wid*64;
  const bf16*ksrc=Kh+(long)lane*DM+wid*8;
  const bf16*vsrc=Vh+(long)(16*(wid&3)+(lane>>2))*DM+(wid>>2)*32+(lane&3)*8;
  const unsigned kdst=lds0+LDS_K+wid*1024, vdst=lds0+LDS_V+wid*1024;
  #define DMA_K(t,slot) glds16(ksrc+(long)(t)*KVBLK*DM,(unsigned)__builtin_amdgcn_readfirstlane(kdst+(slot)))
  #define DMA_V(t,slot) glds16(vsrc+(long)(t)*KVBLK*DM,(unsigned)__builtin_amdgcn_readfirstlane(vdst+(slot)))
  const int vb0=(int)(lds0+LDS_V)+((lane>>4)&1)*32+(lane&3)*8+(4*hi+((lane&15)>>2))*64;
  const char*Kbase=shm+LDS_K; bf16x8 kf[8];
  const lds_cptr shm3=(lds_cptr)shm; const lds_cptr kp0=shm3+LDS_K+hi*1024+r32*16; const lds_cptr vp0=shm3+LDS_V+((lane>>4)&1)*32+(lane&3)*8+(4*hi+((lane&15)>>2))*64;
  const int NT=(q0+QB)/KVBLK;
  DMA_K(0,0);DMA_V(0,0);DMA_K(1,SLOTB);
  bf16x8 qr[4];
  #pragma unroll
  for(int d0=0;d0<4;++d0)qr[d0]=*reinterpret_cast<const bf16x8*>(&Qw[(long)r32*DM+d0*16+hi*8]);
  float mhat=0.f,l_reg=0.f;f32x16 o[2];o[0]=f32x16{};o[1]=f32x16{};f32x16 negm=f32x16{};asm volatile("":"+v"(negm));
  const int qrel=wid*QBLK+r32;
  #define CMASK(P0,P1,t) do{int jb_=(t)-(NT-4); if(jb_>=0)cmask(P0,P1,jb_,qrel,hi);}while(0)
  bool resc=false;
  #define START(P0,P1) do{ const float rm=rowmax(P0,P1); resc=false; \
    { const float dl=rm; mhat=fadd_s(mhat,dl); \
      _Pragma("unroll") for(int r=0;r<16;++r){P0[r]=fsub_s(P0[r],dl);P1[r]=fsub_s(P1[r],dl);} \
      _Pragma("unroll") for(int r=0;r<16;++r)negm[r]=-mhat; asm volatile("":"+v"(negm)); } \
    _Pragma("unroll") for(int r=0;r<16;++r)P0[r]=__builtin_amdgcn_exp2f(P0[r]); }while(0)
  #define RESC() do{ if(resc){ asm volatile("s_waitcnt lgkmcnt(0)":::"memory"); \
      _Pragma("unroll") for(int d_=0;d_<2;++d_) _Pragma("unroll") for(int r=0;r<16;++r)o[d_][r]*=wsf[crow(r,hi)]; } }while(0)
  f32x16 pA0,pA1,pB0,pB1;
  int sl_prev=0,sl_cur=0,sl_next=SLOTB;
  #define ROT() do{sl_prev=sl_cur;sl_cur=sl_next;sl_next=(sl_next==(NSLOT-1)*SLOTB)?0:sl_next+SLOTB;}while(0)
  DMA_K(2,2*SLOTB);
  WAIT_BAR(3);
  qkt(pA0,pA1,Kbase,qr,negm,r32,hi);asm volatile("s_nop 15\n\ts_nop 7":"+v"(pA0),"+v"(pA1));CMASK(pA0,pA1,0);
  START(pA0,pA1);
  _Pragma("unroll") for(int r=0;r<16;++r)pA1[r]=__builtin_amdgcn_exp2f(pA1[r]);
  WAIT_BAR(0);
  DMA_K(3,0);DMA_V(1,SLOTB);
  ROT();
  kload8(kf,kp0+sl_cur);
  WAIT_BAR(2);
  s16x4 vlo[8],vhi[8]; u32x4 pw0,pw1,pw2,pw3;
  #define PKW(P,B) cvtpk_s(P[B],P[B+1])
  #define PAF(k) __builtin_bit_cast(bf16x8,pw##k)
  #define VFR(i) (bf16x8){vlo[i][0],vlo[i][1],vlo[i][2],vlo[i][3],vhi[i][0],vhi[i][1],vhi[i][2],vhi[i][3]}
  #define PIN(x) asm volatile("":"+v"(x))
  #define MX3(a,b,c) __builtin_fmaxf(__builtin_fmaxf((a),(b)),(c))
  #define GAPA(MF,A0,A1,A2,A3,W0,W1,PW) do{ MF; sacc+=A0; sacc+=A1; sacc+=A2; sacc+=A3; PIN(sacc); W0; W1; PIN(PW); SBAR(); }while(0)
  #define EX(v) __builtin_amdgcn_exp2f(v)
  #define GAPB(MF,X,B) do{ MF; X[B]=EX(X[B]); X[B+1]=EX(X[B+1]); X[B+2]=EX(X[B+2]); X[B+3]=EX(X[B+3]); PIN(X); SBAR(); }while(0)
  #define VRD(i) do{ vlo[i]=vtr(vp_+(((i)>>2)*4096+((i)&3)*1024)); vhi[i]=vtr(vp_+(((i)>>2)*4096+((i)&3)*1024+512)); }while(0)
  #define KRD(G,j) do{ if(G){ kload2(kf,kp0+sl_next,j); SBAR(); } }while(0)
  #define STEP(C0,C1,P0,P1,t,GK,GV,GL) do{ SBAR(); \
    const lds_cptr vp_=vp0+sl_prev; \
    VRD(0); SBAR(); float sacc=(P0[0]+P0[1]); \
    GAPA(C0=__builtin_amdgcn_mfma_f32_32x32x16_bf16(kf[0],qr[0],negm,0,0,0), P0[2],P0[3],P0[4],P0[5],     pw0[0]=PKW(P0,0), pw0[1]=PKW(P0,2), pw0); \
    VRD(4); SBAR(); GAPA(C1=__builtin_amdgcn_mfma_f32_32x32x16_bf16(kf[1],qr[0],negm,0,0,0), P0[6],P0[7],P0[8],P0[9],     pw0[2]=PKW(P0,4), pw0[3]=PKW(P0,6), pw0); \
    VRD(1); SBAR(); GAPA(C0=__builtin_amdgcn_mfma_f32_32x32x16_bf16(kf[2],qr[1],C0,0,0,0),   P0[10],P0[11],P0[12],P0[13], pw1[0]=PKW(P0,8), pw1[1]=PKW(P0,10), pw1); \
    VRD(5); SBAR(); GAPA(C1=__builtin_amdgcn_mfma_f32_32x32x16_bf16(kf[3],qr[1],C1,0,0,0),   P0[14],P0[15],P1[0],P1[1],   pw1[2]=PKW(P0,12),pw1[3]=PKW(P0,14), pw1); \
    VRD(2); SBAR(); GAPA(C0=__builtin_amdgcn_mfma_f32_32x32x16_bf16(kf[4],qr[2],C0,0,0,0),   P1[2],P1[3],P1[4],P1[5],     pw2[0]=PKW(P1,0), pw2[1]=PKW(P1,2), pw2); \
    VRD(6); SBAR(); GAPA(C1=__builtin_amdgcn_mfma_f32_32x32x16_bf16(kf[5],qr[2],C1,0,0,0),   P1[6],P1[7],P1[8],P1[9],     pw2[2]=PKW(P1,4), pw2[3]=PKW(P1,6), pw2); \
    VRD(3); SBAR(); GAPA(C0=__builtin_amdgcn_mfma_f32_32x32x16_bf16(kf[6],qr[3],C0,0,0,0),   P1[10],P1[11],P1[12],P1[13], pw3[0]=PKW(P1,8), pw3[1]=PKW(P1,10), pw3); \
    VRD(7); SBAR(); GAPA(C1=__builtin_amdgcn_mfma_f32_32x32x16_bf16(kf[7],qr[3],C1,0,0,0),   P1[14],P1[15],0.f,0.f,       pw3[2]=PKW(P1,12),pw3[3]=PKW(P1,14), pw3); \
    l_reg+=sacc; \
    if(GK){DMA_K((t)+3,sl_cur);} if(GV){DMA_V((t)+1,sl_next);} \
    CMASK(C0,C1,t); \
    { float a=MX3(C0[0],C0[1],C1[0]),b=MX3(C0[2],C0[3],C1[1]); a=MX3(a,C1[2],C1[3]); \
      _Pragma("unroll") for(int r=4;r<16;r+=4){a=MX3(a,C0[r],C0[r+1]);b=MX3(b,C0[r+2],C0[r+3]);a=MX3(a,C1[r],C1[r+1]);b=MX3(b,C1[r+2],C1[r+3]);} \
      float rm=__builtin_fmaxf(a,b); { auto rr=__builtin_amdgcn_permlane32_swap(__float_as_uint(rm),__float_as_uint(rm),false,false); rm=__builtin_fmaxf(__uint_as_float(rr[0]),__uint_as_float(rr[1])); } \
      resc=false; \
      if(__builtin_expect(__any(rm>(float)THRL),0)){ const float dl=__builtin_fmaxf(rm,0.f); mhat+=dl; \
        _Pragma("unroll") for(int r=0;r<16;++r){C0[r]-=dl;C1[r]-=dl;} \
        _Pragma("unroll") for(int r=0;r<16;++r)negm[r]=-mhat; asm volatile("":"+v"(negm)); \
        const float f=__builtin_amdgcn_exp2f(-dl); l_reg*=f; if(hi==0)wsf[r32]=f; resc=true; } } \
    SBAR(); \
    GAPB(o[0]=__builtin_amdgcn_mfma_f32_32x32x16_bf16(PAF(0),VFR(0),o[0],0,0,0), C0,0); \
    GAPB(o[1]=__builtin_amdgcn_mfma_f32_32x32x16_bf16(PAF(0),VFR(4),o[1],0,0,0), C0,4); \
    KRD(GL,0); GAPB(o[0]=__builtin_amdgcn_mfma_f32_32x32x16_bf16(PAF(1),VFR(1),o[0],0,0,0), C0,8); \
    KRD(GL,1); GAPB(o[1]=__builtin_amdgcn_mfma_f32_32x32x16_bf16(PAF(1),VFR(5),o[1],0,0,0), C0,12); \
    KRD(GL,2); GAPB(o[0]=__builtin_amdgcn_mfma_f32_32x32x16_bf16(PAF(2),VFR(2),o[0],0,0,0), C1,0); \
    KRD(GL,3); GAPB(o[1]=__builtin_amdgcn_mfma_f32_32x32x16_bf16(PAF(2),VFR(6),o[1],0,0,0), C1,4); \
    GAPB(o[0]=__builtin_amdgcn_mfma_f32_32x32x16_bf16(PAF(3),VFR(3),o[0],0,0,0), C1,8); \
    GAPB(o[1]=__builtin_amdgcn_mfma_f32_32x32x16_bf16(PAF(3),VFR(7),o[1],0,0,0), C1,12); \
    }while(0)
  int t=1;
  #undef CMASK
  #define CMASK(P0,P1,t) do{}while(0)
  for(;t+5<NT;t+=2){
    STEP(pB0,pB1,pA0,pA1,t,true,true,true);     WAIT_BAR(2); RESC(); ROT();
    STEP(pA0,pA1,pB0,pB1,t+1,true,true,true);   WAIT_BAR(2); RESC(); ROT();
  }
  #undef CMASK
  #define CMASK(P0,P1,t) do{int jb_=(t)-(NT-4); if(jb_>=0)cmask(P0,P1,jb_,qrel,hi);}while(0)
  #define ENDW(tt) do{ if((tt)+3<NT){WAIT_BAR(2);} else if((tt)+2<NT){WAIT_BAR(1);} else {WAIT_BAR(0);} }while(0)
  for(;t+1<NT;t+=2){
    STEP(pB0,pB1,pA0,pA1,t,(t+3<NT),(t+1<NT),(t+1<NT));       ENDW(t);   RESC(); ROT();
    STEP(pA0,pA1,pB0,pB1,t+1,(t+4<NT),(t+2<NT),(t+2<NT));     ENDW(t+1); RESC(); ROT();
  }
  STEP(pB0,pB1,pA0,pA1,NT-1,false,false,false); RESC();
  { float sacc=pB0[0]+pB0[1]; _Pragma("unroll") for(int r=2;r<16;++r)sacc+=pB0[r]; _Pragma("unroll") for(int r=0;r<16;++r)sacc+=pB1[r]; l_reg+=sacc;
    pw0=(u32x4){PKW(pB0,0),PKW(pB0,2),PKW(pB0,4),PKW(pB0,6)};pw1=(u32x4){PKW(pB0,8),PKW(pB0,10),PKW(pB0,12),PKW(pB0,14)};pw2=(u32x4){PKW(pB1,0),PKW(pB1,2),PKW(pB1,4),PKW(pB1,6)};pw3=(u32x4){PKW(pB1,8),PKW(pB1,10),PKW(pB1,12),PKW(pB1,14)};
    SBAR(); pv(o,vb0+sl_cur,PAF(0),PAF(1),PAF(2),PAF(3)); }
  #undef PKW
  #undef PAF
  #undef VFR
  #undef PIN
  #undef MX3
  #undef GAPA
  #undef GAPB
  #undef EX
  #undef VRD
  #undef KRD
  #undef STEP
  #undef ENDW
  {auto rr=__builtin_amdgcn_permlane32_swap(__float_as_uint(l_reg),__float_as_uint(l_reg),false,false);l_reg=__uint_as_float(rr[0])+__uint_as_float(rr[1]);}
  if(hi==0)wsf[32+r32]=l_reg;asm volatile("s_waitcnt lgkmcnt(0)":::"memory");
  float rli[16];
  #pragma unroll
  for(int r=0;r<16;++r)rli[r]=__builtin_amdgcn_rcpf(wsf[32+crow(r,hi)]);
  bf16*Ow=O+(rowbase+q0+wid*QBLK)*DM+hv*D;
  { bf16*stg=(bf16*)(shm+LDS_OST)+wid*2048;
    #pragma unroll
    for(int r=0;r<16;++r){const int orow=crow(r,hi);
      #pragma unroll
      for(int d0=0;d0<2;++d0)stg[orow*64+d0*32+r32]=__float2bfloat16(o[d0][r]*rli[r]);}
    asm volatile("s_waitcnt lgkmcnt(0)":::"memory");
    #pragma unroll
    for(int i=0;i<4;++i){const int row=i*8+(lane>>3),ch=lane&7; const u32x4 v=*(const u32x4*)(stg+row*64+ch*8); ATTN_STORE16(Ow+(long)row*DM+ch*8,v);} }
  asm volatile("s_waitcnt lgkmcnt(0)\n\ts_barrier":::"memory");
  #undef DMA_K
  #undef DMA_V
  #undef CMASK
  #undef START
  #undef RESC
  #undef ROT
}
constexpr int ATTN_LDS_BYTES=LDS_BYTES;
#undef SBAR
#undef WAIT_BAR
}
#define LAS __attribute__((address_space(3)))
typedef unsigned short bf16;
typedef unsigned v4u __attribute__((ext_vector_type(4)));
typedef float f32x4 __attribute__((ext_vector_type(4)));
typedef float f32x16 __attribute__((ext_vector_type(16)));
typedef short bf16x8 __attribute__((ext_vector_type(8)));
constexpr int NWAVES = 8, NTHR = 512;
constexpr int NB = 4, SEQ = 8192, DM = 1024, TT = NB * SEQ, TH = 16384, FF = 4096, NIN = 9216;
constexpr float EPS = 1e-6f;
constexpr size_t MiB = 1u << 20;
constexpr size_t WS_ADA = 0, WS_ROPE = 1 * MiB, WS_WIN = 4 * MiB, WS_WPA = 22 * MiB, WS_WPR = 24 * MiB, WS_WOUT = 26 * MiB, WS_W1 = 28 * MiB, WS_W2 = 36 * MiB;
constexpr size_t WS_XN = 44 * MiB, WS_Y = 108 * MiB, WS_P = 172 * MiB, WS_DEC = 460 * MiB, WS_END = 462 * MiB;
constexpr size_t PBUF = (size_t)TH * 1024;
constexpr size_t DO_O0 = 0, DO_O1 = 32 * MiB, DO_UST = 64 * MiB;
constexpr int LDS_BYTES = 147456;

#define LDS_WAIT() asm volatile("s_waitcnt lgkmcnt(0)" ::: "memory")
__device__ __forceinline__ unsigned f2bf(float f) { unsigned u = __builtin_bit_cast(unsigned, f); return (u + 0x7fffu + ((u >> 16) & 1u)) >> 16; }
__device__ __forceinline__ unsigned pk2(float lo, float hi) { return f2bf(lo) | (f2bf(hi) << 16); }
__device__ __forceinline__ float bflo(unsigned w) { return __uint_as_float(w << 16); }
__device__ __forceinline__ float bfhi(unsigned w) { return __uint_as_float(w & 0xffff0000u); }
__device__ __forceinline__ float wave_sum(float v) {
#pragma unroll
    for (int o = 1; o < 64; o <<= 1) v += __shfl_xor(v, o);
    return v;
}
struct Args { const float* in[21]; const int* pos; float* out; unsigned char* ws; };

__device__ __forceinline__ void p0_transpose_item(const float* W, int K, int N, bf16* WT, LAS float* scr, int item, int lane) {
    const int nblk = N / 32, kb = item / nblk, nb = item % nblk, k0 = 64 * kb, n0 = 32 * nb;
#pragma unroll 8
    for (int i = 0; i < 32; ++i) { const int kk = 2 * i + (lane >> 5); scr[kk * 33 + (lane & 31)] = W[(size_t)(k0 + kk) * N + n0 + (lane & 31)]; }
    LDS_WAIT(); asm volatile("" ::: "memory");
    const int c = lane & 7;
#pragma unroll
    for (int j = 0; j < 4; ++j) { const int n = (lane >> 3) + 8 * j; const LAS float* s = scr + (8 * c) * 33 + n;
        v4u o; o.x = pk2(s[0 * 33], s[1 * 33]); o.y = pk2(s[2 * 33], s[3 * 33]); o.z = pk2(s[4 * 33], s[5 * 33]); o.w = pk2(s[6 * 33], s[7 * 33]);
        *(v4u*)(WT + (size_t)(n0 + n) * K + k0 + 8 * c) = o; }
    LDS_WAIT(); asm volatile("" ::: "memory");
}

__device__ __forceinline__ void norm_mod_row(const float* xrow, const float* w, const float* sc, const float* sh, bf16* orow, int lane) {
    const f32x4* xr = (const f32x4*)xrow + lane;
    f32x4 v[4]; float s = 0.f;
#pragma unroll
    for (int j = 0; j < 4; ++j) { v[j] = xr[64 * j]; s += (v[j].x * v[j].x + v[j].y * v[j].y) + (v[j].z * v[j].z + v[j].w * v[j].w); }
    const float rinv = 1.0f / sqrtf(wave_sum(s) * (1.f / 1024.f) + EPS);
    unsigned long long* o8 = (unsigned long long*)orow + lane;
#pragma unroll
    for (int j = 0; j < 4; ++j) {
        const f32x4 wv = ((const f32x4*)w)[lane + 64 * j], scv = ((const f32x4*)sc)[lane + 64 * j], shv = ((const f32x4*)sh)[lane + 64 * j];
        const f32x4 o = v[j] * rinv * wv * (scv + 1.0f) + shv;
        o8[64 * j] = (unsigned long long)pk2(o.x, o.y) | ((unsigned long long)pk2(o.z, o.w) << 32);
    }
}

constexpr int HG_G = 0, HG_TOT = 33792, HG_QP = 35840, HG_KP = 53248, HG_QPP = 70656, HG_VT = 88064, HG_PP = 106496, HG_RED = 115712;
constexpr int GST = 132;
__device__ __forceinline__ int crow(int r, int hi) { return (r & 3) + 8 * (r >> 2) + 4 * hi; }

__device__ __forceinline__ void hg_gates(LAS unsigned char* lds, const bf16* RF, size_t tile_off, const float* lbl, int h, int tid, float (&kk)[2][8]) {
    const int r0 = tid >> 4, c8 = (tid & 15) * 8;
    LAS float* G = (LAS float*)(lds + HG_G); LAS float* TOT = (LAS float*)(lds + HG_TOT);
    float lb[8];
#pragma unroll
    for (int i = 0; i < 8; ++i) { const int c = h * 128 + c8 + i; lb[i] = 1.0f / (1.0f + __expf(lbl[c] - lbl[1024 + c])); }
#pragma unroll
    for (int p = 0; p < 2; ++p) {
        const int r = r0 + 32 * p;
        const v4u w = *(const v4u*)(RF + tile_off + (size_t)r * 1024 + c8);
        float x[8] = {bflo(w.x), bfhi(w.x), bflo(w.y), bfhi(w.y), bflo(w.z), bfhi(w.z), bflo(w.w), bfhi(w.w)};
        float g[8];
#pragma unroll
        for (int i = 0; i < 8; ++i) { const float sg = 1.0f / (1.0f + __expf(-x[i])); const float f = lb[i] + (1.0f - lb[i]) * sg; g[i] = __logf(f); kk[p][i] = (1.0f - lb[i]) * (1.0f - sg); }
        *(LAS f32x4*)(G + r * GST + c8) = (f32x4){g[0], g[1], g[2], g[3]};
        *(LAS f32x4*)(G + r * GST + c8 + 4) = (f32x4){g[4], g[5], g[6], g[7]};
    }
    __syncthreads();
    {
        const int k = tid & 127, seg = tid >> 7; float v[16];
#pragma unroll
        for (int i = 0; i < 16; ++i) v[i] = G[(seg * 16 + i) * GST + k];
#pragma unroll
        for (int i = 1; i < 16; ++i) v[i] += v[i - 1];
        TOT[seg * 128 + k] = v[15];
        __syncthreads();
        float off = 0.f;
#pragma unroll
        for (int s = 0; s < 3; ++s) if (s < seg) off += TOT[s * 128 + k];
#pragma unroll
        for (int i = 0; i < 16; ++i) G[(seg * 16 + i) * GST + k] = v[i] + off;
    }
    __syncthreads();
}
__device__ __forceinline__ void ld8(const LAS float* p, float (&o)[8]) { const f32x4 a = *(const LAS f32x4*)p, b = *(const LAS f32x4*)(p + 4); o[0] = a[0]; o[1] = a[1]; o[2] = a[2]; o[3] = a[3]; o[4] = b[0]; o[5] = b[1]; o[6] = b[2]; o[7] = b[3]; }
__device__ __forceinline__ bf16x8 ldsfrag(const LAS unsigned char* p) { return *(const LAS bf16x8*)p; }

__device__ __forceinline__ void hg_unit_state(LAS unsigned char* lds, const bf16* RF, const bf16* RI, const float* lbl, bf16* Ust, float* dec, int unit, int tid) {
    const int bl = unit >> 10, h = (unit >> 7) & 7, c = unit & 127;
    const size_t tile_off = ((size_t)bl * SEQ + (size_t)c * 64) * 1024 + h * 128;
    const int r0 = tid >> 4, c8 = (tid & 15) * 8, lane = tid & 63, wid = tid >> 6, r32 = lane & 31, hi = lane >> 5;
    v4u vv[2];
#pragma unroll
    for (int p = 0; p < 2; ++p) vv[p] = *(const v4u*)(RI + tile_off + (size_t)(r0 + 32 * p) * 1024 + c8);
    float kk[2][8];
    hg_gates(lds, RF, tile_off, lbl, h, tid, kk);
    const LAS float* G = (const LAS float*)(lds + HG_G);
    LAS bf16* KT = (LAS bf16*)(lds + HG_KP); LAS bf16* VT = (LAS bf16*)(lds + HG_VT);
    float bl8[8]; ld8(G + 63 * GST + c8, bl8);
#pragma unroll
    for (int p = 0; p < 2; ++p) {
        const int r = r0 + 32 * p; float b8[8]; ld8(G + r * GST + c8, b8);
        const unsigned vw[4] = {vv[p].x, vv[p].y, vv[p].z, vv[p].w};
#pragma unroll
        for (int i = 0; i < 8; ++i) {
            KT[(c8 + i) * 72 + r] = (bf16)f2bf(kk[p][i] * __expf(bl8[i] - b8[i]));
            VT[(c8 + i) * 72 + r] = (bf16)((i & 1) ? (vw[i >> 1] >> 16) : (vw[i >> 1] & 0xffffu));
        }
    }
    if (tid < 128) dec[(size_t)unit * 128 + tid] = __expf(G[63 * GST + tid]);
    __syncthreads();
    const int jb = wid >> 1, kb0 = (wid & 1) * 2;
    f32x16 a0 = {}, a1 = {};
#pragma unroll
    for (int ks = 0; ks < 4; ++ks) {
        const bf16x8 av = ldsfrag(lds + HG_VT + ((jb * 32 + r32) * 72 + ks * 16 + hi * 8) * 2);
        const bf16x8 b0 = ldsfrag(lds + HG_KP + ((kb0 * 32 + r32) * 72 + ks * 16 + hi * 8) * 2);
        const bf16x8 b1 = ldsfrag(lds + HG_KP + (((kb0 + 1) * 32 + r32) * 72 + ks * 16 + hi * 8) * 2);
        a0 = __builtin_amdgcn_mfma_f32_32x32x16_bf16(av, b0, a0, 0, 0, 0);
        a1 = __builtin_amdgcn_mfma_f32_32x32x16_bf16(av, b1, a1, 0, 0, 0);
    }
    bf16* up = Ust + (size_t)unit * 16384;
#pragma unroll
    for (int r = 0; r < 16; ++r) { const int j = jb * 32 + crow(r, hi);
        up[j * 128 + kb0 * 32 + r32] = (bf16)f2bf(a0[r]); up[j * 128 + (kb0 + 1) * 32 + r32] = (bf16)f2bf(a1[r]); }
    __syncthreads();
}

__device__ __forceinline__ void hg_unit_out(LAS unsigned char* lds, bf16* RQ, const bf16* RF, const bf16* RI, const bf16* RG, const float* lbl, const float* rnw,
                                            const bf16* Sin, int unit, int tid) {
    const int bl = unit >> 10, h = (unit >> 7) & 7, c = unit & 127;
    const size_t tile_off = ((size_t)bl * SEQ + (size_t)c * 64) * 1024 + h * 128;
    const int r0 = tid >> 4, c8 = (tid & 15) * 8, lane = tid & 63, wid = tid >> 6, r32 = lane & 31, hi = lane >> 5;
    v4u vv[2], qq[2];
#pragma unroll
    for (int p = 0; p < 2; ++p) { vv[p] = *(const v4u*)(RI + tile_off + (size_t)(r0 + 32 * p) * 1024 + c8); qq[p] = *(const v4u*)(RQ + tile_off + (size_t)(r0 + 32 * p) * 1024 + c8); }
    const int tb = wid & 1, jb = wid >> 1;
    v4u sf[8];
    { const bf16* sp = Sin + (size_t)unit * 16384 + (size_t)(jb * 32 + r32) * 128 + hi * 8;
#pragma unroll
      for (int ks = 0; ks < 8; ++ks) sf[ks] = *(const v4u*)(sp + ks * 16); }
    float kk[2][8];
    hg_gates(lds, RF, tile_off, lbl, h, tid, kk);
    const LAS float* G = (const LAS float*)(lds + HG_G);
    LAS bf16* VT = (LAS bf16*)(lds + HG_VT);
    float bm8[8]; ld8(G + 31 * GST + c8, bm8);
#pragma unroll
    for (int p = 0; p < 2; ++p) {
        const int r = r0 + 32 * p; float b8[8]; ld8(G + r * GST + c8, b8);
        const unsigned vw[4] = {vv[p].x, vv[p].y, vv[p].z, vv[p].w};
        const float q8[8] = {bflo(qq[p].x), bfhi(qq[p].x), bflo(qq[p].y), bfhi(qq[p].y), bflo(qq[p].z), bfhi(qq[p].z), bflo(qq[p].w), bfhi(qq[p].w)};
        float qp[8], kp[8], qpp[8];
#pragma unroll
        for (int i = 0; i < 8; ++i) { const float e = __expf(b8[i] - bm8[i]); qp[i] = q8[i] * e; kp[i] = kk[p][i] * __expf(bm8[i] - b8[i]); qpp[i] = q8[i] * __expf(b8[i]);
            VT[(c8 + i) * 72 + r] = (bf16)((i & 1) ? (vw[i >> 1] >> 16) : (vw[i >> 1] & 0xffffu)); }
        *(LAS v4u*)(lds + HG_QP + (r * 136 + c8) * 2) = (v4u){pk2(qp[0], qp[1]), pk2(qp[2], qp[3]), pk2(qp[4], qp[5]), pk2(qp[6], qp[7])};
        *(LAS v4u*)(lds + HG_KP + (r * 136 + c8) * 2) = (v4u){pk2(kp[0], kp[1]), pk2(kp[2], kp[3]), pk2(kp[4], kp[5]), pk2(kp[6], kp[7])};
        *(LAS v4u*)(lds + HG_QPP + (r * 136 + c8) * 2) = (v4u){pk2(qpp[0], qpp[1]), pk2(qpp[2], qpp[3]), pk2(qpp[4], qpp[5]), pk2(qpp[6], qpp[7])};
    }
    __syncthreads();
    if (wid < 4) {
        const int stb = wid & 1, ssb = wid >> 1;
        f32x16 sc = {};
        if (ssb <= stb) {
#pragma unroll
            for (int ks = 0; ks < 8; ++ks) {
                const bf16x8 av = ldsfrag(lds + HG_QP + ((stb * 32 + r32) * 136 + ks * 16 + hi * 8) * 2);
                const bf16x8 bv = ldsfrag(lds + HG_KP + ((ssb * 32 + r32) * 136 + ks * 16 + hi * 8) * 2);
                sc = __builtin_amdgcn_mfma_f32_32x32x16_bf16(av, bv, sc, 0, 0, 0);
            }
        }
        LAS bf16* PP = (LAS bf16*)(lds + HG_PP);
        const int s = ssb * 32 + r32;
#pragma unroll
        for (int r = 0; r < 16; ++r) { const int t = stb * 32 + crow(r, hi); const float v = (ssb <= stb && s <= t) ? sc[r] : 0.f; PP[t * 72 + s] = (bf16)f2bf(v); }
    }
    __syncthreads();
    f32x16 o = {};
#pragma unroll
    for (int ks = 0; ks < 4; ++ks) {
        const bf16x8 av = ldsfrag(lds + HG_PP + ((tb * 32 + r32) * 72 + ks * 16 + hi * 8) * 2);
        const bf16x8 bv = ldsfrag(lds + HG_VT + ((jb * 32 + r32) * 72 + ks * 16 + hi * 8) * 2);
        o = __builtin_amdgcn_mfma_f32_32x32x16_bf16(av, bv, o, 0, 0, 0);
    }
#pragma unroll
    for (int ks = 0; ks < 8; ++ks) {
        const bf16x8 av = ldsfrag(lds + HG_QPP + ((tb * 32 + r32) * 136 + ks * 16 + hi * 8) * 2);
        o = __builtin_amdgcn_mfma_f32_32x32x16_bf16(av, __builtin_bit_cast(bf16x8, sf[ks]), o, 0, 0, 0);
    }
    LAS float* RED = (LAS float*)(lds + HG_RED);
    float ssq[16];
#pragma unroll
    for (int r = 0; r < 16; ++r) { float s = o[r] * o[r]; s += __shfl_xor(s, 1); s += __shfl_xor(s, 2); s += __shfl_xor(s, 4); s += __shfl_xor(s, 8); s += __shfl_xor(s, 16); ssq[r] = s; }
    if (r32 == 0) {
#pragma unroll
        for (int r = 0; r < 16; ++r) RED[jb * 64 + tb * 32 + crow(r, hi)] = ssq[r];
    }
    __syncthreads();
    const int j = jb * 32 + r32; const float wj = rnw[j];
#pragma unroll
    for (int r = 0; r < 16; ++r) {
        const int t = tb * 32 + crow(r, hi);
        const float tot = RED[t] + RED[64 + t] + RED[128 + t] + RED[192 + t];
        const float rstd = 1.0f / sqrtf(tot * (1.f / 128.f) + EPS);
        const size_t go = tile_off + (size_t)t * 1024 + j;
        const float g = __uint_as_float((unsigned)RG[go] << 16);
        const float sl = g / (1.0f + __expf(-g));
        RQ[go] = (bf16)f2bf(o[r] * rstd * wj * sl);
    }
    __syncthreads();
}

__global__ void __launch_bounds__(NTHR, 2) fused_fwd(Args args) {
    extern __shared__ __attribute__((aligned(16))) unsigned char lds_raw[];
    cg::grid_group grid = cg::this_grid();
    LAS unsigned char* lds = (LAS unsigned char*)lds_raw;
    const int tid = threadIdx.x, lane = tid & 63, wave = __builtin_amdgcn_readfirstlane(tid >> 6);
    const int G = gridDim.x, bx = blockIdx.x;
    const int vcu = (G % 8 == 0) ? (bx % 8) * (G / 8) + bx / 8 : bx;
    const int gw = vcu * NWAVES + wave, NGW = G * NWAVES;
    unsigned char* ws = args.ws;
    const float* x = args.in[0]; const float* cvec = args.in[1];
    const float* w_ada = args.in[3]; const float* b_ada = args.in[4]; const float* norm_mix = args.in[5]; const float* w_in = args.in[6];
    const float* lam_q1 = args.in[7]; const float* lam_k1 = args.in[8]; const float* lam_q2 = args.in[9]; const float* lam_k2 = args.in[10];
    const float* subln_w = args.in[11]; const float* lb_logits = args.in[12]; const float* rec_norm_w = args.in[13];
    const float* w_pa = args.in[14]; const float* w_pr = args.in[15]; const float* w_out = args.in[16]; const float* norm_mlp = args.in[17];
    const float* w1 = args.in[18]; const float* w2 = args.in[19]; const float* norm_final = args.in[20];
    float* ada = (float*)(ws + WS_ADA); float* rope = (float*)(ws + WS_ROPE);
    bf16* Win_t = (bf16*)(ws + WS_WIN); bf16* Wpa_t = (bf16*)(ws + WS_WPA); bf16* Wpr_t = (bf16*)(ws + WS_WPR); bf16* Wout_t = (bf16*)(ws + WS_WOUT);
    bf16* W1_t = (bf16*)(ws + WS_W1); bf16* W2_t = (bf16*)(ws + WS_W2);
    bf16* XN = (bf16*)(ws + WS_XN); bf16* Y = (bf16*)(ws + WS_Y); bf16* P = (bf16*)(ws + WS_P); float* dec = (float*)(ws + WS_DEC);
    bf16* Pq = P, *Pk = P + PBUF, *Pv = P + 2 * PBUF, *Prq = P + 3 * PBUF, *Prf = P + 4 * PBUF, *Pri = P + 5 * PBUF, *Prg = P + 6 * PBUF, *Pga = P + 7 * PBUF, *Pgr = P + 8 * PBUF;
    float* Y1 = (float*)P;
    bf16* Oa = Pv;
    bf16* UH = P;
    unsigned char* dob = (unsigned char*)args.out;
    bf16* O0 = (bf16*)(dob + DO_O0); bf16* O1 = (bf16*)(dob + DO_O1); bf16* Ust = (bf16*)(dob + DO_UST);

    if (bx < 96) {
        LAS float* scs = (LAS float*)lds;
        LAS float* part = (LAS float*)(lds + 16384);
        for (int i = tid; i < 4096; i += NTHR) { const float v = cvec[i]; scs[i] = v / (1.0f + __expf(-v)); }
        __syncthreads();
        const int n = bx * 64 + lane; float a0 = 0.f, a1 = 0.f, a2 = 0.f, a3 = 0.f;
        const float* wp = w_ada + (size_t)(wave * 128) * 6144 + n;
#pragma unroll 8
        for (int k = 0; k < 128; ++k) { const float wv = wp[(size_t)k * 6144]; const int kk = wave * 128 + k;
            a0 += scs[kk] * wv; a1 += scs[1024 + kk] * wv; a2 += scs[2048 + kk] * wv; a3 += scs[3072 + kk] * wv; }
        part[(wave * 4 + 0) * 64 + lane] = a0; part[(wave * 4 + 1) * 64 + lane] = a1; part[(wave * 4 + 2) * 64 + lane] = a2; part[(wave * 4 + 3) * 64 + lane] = a3;
        __syncthreads();
        if (wave < 4) { float s = b_ada[n];
#pragma unroll
            for (int w = 0; w < 8; ++w) s += part[(w * 4 + wave) * 64 + lane];
            ada[wave * 6144 + n] = s; }
        __syncthreads();
    }
    {
        LAS float* scr = (LAS float*)(lds + wave * 16384);
        constexpr int I_IN = 16 * (NIN / 32), I_SQ = 16 * 32, I_1 = 16 * (FF / 32), I_2 = (FF / 64) * 32;
        constexpr int NITEMS = I_IN + 3 * I_SQ + I_1 + I_2;
        for (int it = gw; it < NITEMS; it += NGW) {
            int r = it;
            if (r < I_IN) { p0_transpose_item(w_in, DM, NIN, Win_t, scr, r, lane); continue; } r -= I_IN;
            if (r < I_SQ) { p0_transpose_item(w_pa, DM, DM, Wpa_t, scr, r, lane); continue; } r -= I_SQ;
            if (r < I_SQ) { p0_transpose_item(w_pr, DM, DM, Wpr_t, scr, r, lane); continue; } r -= I_SQ;
            if (r < I_SQ) { p0_transpose_item(w_out, DM, DM, Wout_t, scr, r, lane); continue; } r -= I_SQ;
            if (r < I_1) { p0_transpose_item(w1, DM, FF, W1_t, scr, r, lane); continue; } r -= I_1;
            p0_transpose_item(w2, FF, DM, W2_t, scr, r, lane);
        }
        const float invf[8] = {1.0f, 0.1939227432012558f, 0.03760603070259094f, 0.007292664609849453f, 0.0014142135623842478f, 0.00027424818836152554f, 5.318296098266728e-05f, 1.0313386155758053e-05f};
        for (int row = bx * NTHR + tid; row < TT; row += G * NTHR) { const float pf = (float)args.pos[row];
#pragma unroll
            for (int i = 0; i < 8; ++i) { const float ang = pf * invf[i]; float sv, cv; sincosf(ang, &sv, &cv); rope[row * 16 + i] = cv; rope[row * 16 + 8 + i] = sv; } }
    }
    grid.sync();
    for (int m = gw; m < TT; m += NGW) { const int b = m >> 13;
        norm_mod_row(x + (size_t)m * DM, norm_mix, ada + b * 6144 + 1024, ada + b * 6144, XN + (size_t)m * DM, lane); }
    grid.sync();

    for (int half = 0; half < 2; ++half) {
        { pg8::Gemm g{XN + (size_t)half * TH * DM, Win_t, TH, NIN, DM}; pg8::StaticOrder S; S.init(TH, NIN, G, bx);
          pg8::EpiInProj E{P, rope + (size_t)half * TH * 16};
          pg8::gemm_phase<pg8::EpiInProj, pg8::StaticOrder, true, true>(lds, g, S, E); }
        grid.sync();
        for (int cb = vcu; cb < 512; cb += G) {
            const int s = cb & 7, vb = cb >> 3;
            for (int i = 0; i < 4; ++i) {
                const int qb = (i == 0) ? s : (i == 1) ? 15 - s : (i == 2) ? 16 + s : 31 - s;
                const int b = vb >> 5, h = (vb >> 2) & 7, m = (vb >> 1) & 1, e = vb & 1;
                attn_body::attn_unit<8>(b, h * 2 + m, h * 2 + e, qb, (const attn_body::bf16*)Pq, (const attn_body::bf16*)Pk, (const attn_body::bf16*)Pv,
                                        (attn_body::bf16*)(m ? O1 : O0), (char*)lds_raw);
            }
        }
        { const int t3 = fresh_tid(); for (int u = vcu; u < 2048; u += G) hg_unit_state(lds, Prf, Pri, lb_logits, Ust, dec, u, t3); }
        grid.sync();
        for (int gid = vcu * NTHR + fresh_tid(); gid < 131072; gid += G * NTHR) {
            const int bh = gid >> 13, e2 = gid & 8191, k0 = (2 * e2) & 127;
            unsigned* up = (unsigned*)(Ust + (size_t)bh * 128 * 16384 + 2 * e2);
            const float* dp = dec + (size_t)bh * 128 * 128 + k0;
            float s0 = 0.f, s1 = 0.f;
            for (int c0 = 0; c0 < 128; c0 += 16) {
                unsigned uu[16]; float d0[16], d1[16];
#pragma unroll
                for (int i = 0; i < 16; ++i) { uu[i] = up[(size_t)(c0 + i) * 8192]; const float2 dd = *(const float2*)(dp + (c0 + i) * 128); d0[i] = dd.x; d1[i] = dd.y; }
#pragma unroll
                for (int i = 0; i < 16; ++i) { up[(size_t)(c0 + i) * 8192] = pk2(s0, s1); s0 = d0[i] * s0 + bflo(uu[i]); s1 = d1[i] * s1 + bfhi(uu[i]); }
            }
        }
        grid.sync();
        { const int t5 = fresh_tid(); for (int u = vcu; u < 2048; u += G) hg_unit_out(lds, Prq, Prf, Pri, Prg, lb_logits, rec_norm_w, Ust, u, t5); }
        { const int lane = fresh_tid() & 63;
          float lam; { const float d1 = wave_sum(lam_q1[lane] * lam_k1[lane]), d2 = wave_sum(lam_q2[lane] * lam_k2[lane]); lam = __expf(d1) - __expf(d2) + 0.2f; }
        for (int m = gw; m < TH; m += NGW) {
            const v4u* a = (const v4u*)(O0 + (size_t)m * DM) + lane * 2; const v4u* b = (const v4u*)(O1 + (size_t)m * DM) + lane * 2;
            const v4u a0 = a[0], a1 = a[1], b0 = b[0], b1 = b[1];
            const unsigned aw[8] = {a0.x, a0.y, a0.z, a0.w, a1.x, a1.y, a1.z, a1.w}, bw[8] = {b0.x, b0.y, b0.z, b0.w, b1.x, b1.y, b1.z, b1.w};
            float o[16]; float ss = 0.f;
#pragma unroll
            for (int i = 0; i < 8; ++i) { o[2 * i] = bflo(aw[i]) - lam * bflo(bw[i]); o[2 * i + 1] = bfhi(aw[i]) - lam * bfhi(bw[i]); ss += o[2 * i] * o[2 * i] + o[2 * i + 1] * o[2 * i + 1]; }
            ss += __shfl_xor(ss, 1); ss += __shfl_xor(ss, 2); ss += __shfl_xor(ss, 4);
            const float rstd = 0.8f / sqrtf(ss * (1.f / 128.f) + EPS);
            const float* wp = subln_w + (lane & 7) * 16;
            unsigned ow[8];
#pragma unroll
            for (int i = 0; i < 8; ++i) ow[i] = pk2(o[2 * i] * rstd * wp[2 * i], o[2 * i + 1] * rstd * wp[2 * i + 1]);
            v4u* op = (v4u*)(Oa + (size_t)m * DM) + lane * 2;
            op[0] = (v4u){ow[0], ow[1], ow[2], ow[3]}; op[1] = (v4u){ow[4], ow[5], ow[6], ow[7]};
        } }
        grid.sync();
        { pg8::Gemm g{Oa, Wpa_t, TH, DM, DM}; pg8::StaticOrder S; S.init(TH, DM, G, bx);
          pg8::EpiGate1 E{Pga, Y1};
          pg8::gemm_phase<pg8::EpiGate1, pg8::StaticOrder, true, true>(lds, g, S, E); }
        grid.sync();
        { pg8::Gemm g{Prq, Wpr_t, TH, DM, DM}; pg8::StaticOrder S; S.init(TH, DM, G, bx);
          pg8::EpiGate2 E{Pgr, Y1, Y + (size_t)half * TH * DM};
          pg8::gemm_phase<pg8::EpiGate2, pg8::StaticOrder, true, true>(lds, g, S, E); }
        grid.sync();
    }
    { pg8::Gemm g{Y, Wout_t, TT, DM, DM}; pg8::StaticOrder S; S.init(TT, DM, G, bx);
      pg8::EpiRes E{x, args.out, ada + 2048};
      pg8::gemm_phase<pg8::EpiRes, pg8::StaticOrder, true, true>(lds, g, S, E); }
    grid.sync();
    for (int m = gw; m < TT; m += NGW) { const int b = m >> 13;
        norm_mod_row(args.out + (size_t)m * DM, norm_mlp, ada + b * 6144 + 4096, ada + b * 6144 + 3072, XN + (size_t)m * DM, lane); }
    grid.sync();
    { pg8::Gemm g{XN, W1_t, TT, FF, DM}; pg8::StaticOrder S; S.init(TT, FF, G, bx);
      pg8::EpiRelu2 E{UH, FF};
      pg8::gemm_phase<pg8::EpiRelu2, pg8::StaticOrder, true, true>(lds, g, S, E); }
    grid.sync();
    { pg8::Gemm g{UH, W2_t, TT, DM, FF}; pg8::StaticOrder S; S.init(TT, DM, G, bx);
      pg8::EpiRes E{args.out, args.out, ada + 5120};
      pg8::gemm_phase<pg8::EpiRes, pg8::StaticOrder, true, true>(lds, g, S, E); }
    grid.sync();
    for (int m = gw; m < TT; m += NGW) {
        f32x4* xr = (f32x4*)(args.out + (size_t)m * DM) + lane;
        f32x4 v[4]; float s = 0.f;
#pragma unroll
        for (int j = 0; j < 4; ++j) { v[j] = xr[64 * j]; s += (v[j].x * v[j].x + v[j].y * v[j].y) + (v[j].z * v[j].z + v[j].w * v[j].w); }
        const float rinv = 1.0f / sqrtf(wave_sum(s) * (1.f / 1024.f) + EPS);
#pragma unroll
        for (int j = 0; j < 4; ++j) xr[64 * j] = v[j] * rinv * ((const f32x4*)norm_final)[lane + 64 * j];
    }
}

extern "C" void kernel_launch(void* const* d_in, const int* in_sizes, int n_in, void* d_out, int out_size, void* d_ws, size_t ws_size, hipStream_t stream) {
    static int grid = 0;
    if (grid == 0) {
        if (n_in != 21 || in_sizes[0] != TT * DM || out_size != TT * DM || ws_size < WS_END) {
            fprintf(stderr, "kernel_launch: unexpected shapes: n_in %d in0 %d out %d ws %zu (need %zu)\n", n_in, n_in > 0 ? in_sizes[0] : -1, out_size, ws_size, (size_t)WS_END); grid = -1; return; }
        int dev = 0, cus = 0, per_cu = 0;
        hipGetDevice(&dev); hipDeviceGetAttribute(&cus, hipDeviceAttributeMultiprocessorCount, dev);
        if (hipFuncSetAttribute((const void*)fused_fwd, hipFuncAttributeMaxDynamicSharedMemorySize, LDS_BYTES) != hipSuccess) { fprintf(stderr, "kernel_launch: hipFuncSetAttribute failed\n"); grid = -1; return; }
        if (hipOccupancyMaxActiveBlocksPerMultiprocessor(&per_cu, (const void*)fused_fwd, NTHR, LDS_BYTES) != hipSuccess || per_cu < 1) { fprintf(stderr, "kernel_launch: occupancy query says %d\n", per_cu); per_cu = 1; }
        (void)hipGetLastError();
        grid = cus * 1;
        (void)per_cu;
    }
    if (grid < 0) return;
    Args a{};
    for (int i = 0; i < 21; ++i) a.in[i] = (const float*)d_in[i];
    a.pos = (const int*)d_in[2]; a.out = (float*)d_out; a.ws = (unsigned char*)d_ws;
    void* kargs[] = {&a};
    hipError_t e = hipLaunchCooperativeKernel((const void*)fused_fwd, dim3(grid), dim3(NTHR), kargs, LDS_BYTES, stream);
    if (e != hipSuccess) fprintf(stderr, "cooperative launch failed: %s (grid %d)\n", hipGetErrorString(e), grid);
}
```

```cpp
#include <hip/hip_runtime.h>
#include <hip/hip_cooperative_groups.h>
#include <cstdio>
#include <cstdint>
namespace cg = cooperative_groups;
__device__ __forceinline__ int fresh_tid() { int t = threadIdx.x; asm volatile("" : "+v"(t)); return t; }
namespace pg8 {
#define PG8_LAS __attribute__((address_space(3)))
typedef unsigned short bf16_t;
typedef short bf16x8 __attribute__((ext_vector_type(8)));
typedef float f32x4 __attribute__((ext_vector_type(4)));
typedef unsigned u32x4 __attribute__((ext_vector_type(4)));
constexpr int BM = 256, BK = 64, HALF = 128, HTB = HALF * BK * 2  , STAGE_BYTES = 8 * HTB, NXCD = 8, WGM = 8;

__host__ __device__ __forceinline__ int lds_byte(int r, int c) { const int st = (r >> 4) * 2 + (c >> 5), rr = r & 15, cc = c & 31, ob = rr * 64 + cc * 2; return st * 1024 + (ob ^ (((ob >> 9) & 1) << 5)); }
__host__ __device__ __forceinline__ void stage_rc(int b, int& R, int& C) { const int st = b / 1024, sb = b % 1024, swz = sb ^ (((sb >> 9) & 1) << 5); R = (st >> 1) * 16 + swz / 64; C = (st & 1) * 32 + (swz % 64) / 2; }
__host__ __device__ __forceinline__ int perm32(int rho) { const int n = rho >> 4, i = rho & 15; return 8 * (i >> 2) + 4 * n + (i & 3); }

struct Unit { int pm, pn; };
struct Gemm { const bf16_t* A; const bf16_t* Bt; int M, N, K; };

struct StaticOrder {
    int nM, nN, nwg, G, c;
    __host__ __device__ void init(int M, int N, int G_, int c_) { nM = M / BM; nN = N / BM; nwg = nM * nN; G = G_; c = c_; }
    __host__ __device__ bool next(int i, Unit& u) const {
        const long L = (long)i * G + c; if (L >= nwg) return false;
        int wgid = (int)L; { const int q = nwg / NXCD, r = nwg % NXCD, xcd = wgid % NXCD, off = wgid / NXCD; wgid = (xcd < r ? xcd * (q + 1) : r * (q + 1) + (xcd - r) * q) + off; }
        const int nig = WGM * nN, gid = wgid / nig, fm = gid * WGM, gsz = (nM - fm) < WGM ? (nM - fm) : WGM;
        u.pm = fm + ((wgid % nig) % gsz); u.pn = (wgid % nig) / gsz; return true;
    }
    __device__ __forceinline__ void a_ready(const Unit&) const {}
    __device__ __forceinline__ void done(const Unit&) const {}
};

__device__ __forceinline__ unsigned cvt_pk_bf16(float lo, float hi) { unsigned r; asm volatile("v_cvt_pk_bf16_f32 %0, %1, %2" : "=v"(r) : "v"(lo), "v"(hi)); return r; }
__device__ __forceinline__ float bf_lo(unsigned w) { return __uint_as_float(w << 16); }
__device__ __forceinline__ float bf_hi(unsigned w) { return __uint_as_float(w & 0xffff0000u); }
__device__ __forceinline__ float sigmoidf_(float x) { return __builtin_amdgcn_rcpf(1.0f + __expf(-x)); }
constexpr int TH_ROWS = 16384;
constexpr float QSCALE = 0.125f * 1.4426950408889634f;

struct EpiInProj {
    static constexpr bool PERM = true, AFTER_DRAIN = false;
    bf16_t* P; const float* rope;
    __device__ __forceinline__ void operator()(const f32x4 (&acc)[2][2][4][2], const Unit& u, int wr, int wc, int fr, int fq) const {
        const int t = u.pn >> 2, colt = (u.pn & 3) * 256;
        bf16_t* base = P + (size_t)t * TH_ROWS * 1024;
        const int row0 = u.pm * BM + wr * 64 + fr, col0 = colt + wc * 32 + 8 * fq;
        const bool isrope = (t < 2) && ((wc & 1) == 0);
        const float sc = (t == 0) ? QSCALE : 1.f;
        const float sgn = (fq == 0) ? -1.f : ((fq == 1) ? 1.f : 0.f);
#pragma unroll
        for (int ai = 0; ai < 2; ++ai)
#pragma unroll
            for (int m = 0; m < 4; ++m) {
                const int row = row0 + ai * HALF + m * 16;
                f32x4 c0 = {1.f, 1.f, 1.f, 1.f}, c1 = c0, s0 = {0.f, 0.f, 0.f, 0.f}, s1 = s0;
                if (isrope) { const f32x4* rp = (const f32x4*)(rope + (size_t)row * 16); f32x4 a = rp[0], b = rp[1], c = rp[2], d = rp[3];
                    if (fq < 2) { c0 = a; c1 = b; } s0 = c * sgn; s1 = d * sgn; }
                bf16_t* rowp = base + (size_t)row * 1024 + col0;
#pragma unroll
                for (int bj = 0; bj < 2; ++bj) {
                    f32x4 v0 = acc[ai][bj][m][0], v1 = acc[ai][bj][m][1];
                    if (isrope) {
                        f32x4 p0, p1;
#pragma unroll
                        for (int j = 0; j < 4; ++j) { p0[j] = __shfl_xor(v0[j], 16); p1[j] = __shfl_xor(v1[j], 16); }
                        v0 = v0 * c0 + p0 * s0; v1 = v1 * c1 + p1 * s1;
                    }
                    v0 = v0 * sc; v1 = v1 * sc;
                    u32x4 w; w.x = cvt_pk_bf16(v0[0], v0[1]); w.y = cvt_pk_bf16(v0[2], v0[3]); w.z = cvt_pk_bf16(v1[0], v1[1]); w.w = cvt_pk_bf16(v1[2], v1[3]);
                    *(u32x4*)(rowp + bj * HALF) = w;
                }
            }
    }
};
struct EpiGate1 {
    static constexpr bool PERM = true, AFTER_DRAIN = false;
    const bf16_t* gate; float* Y1;
    __device__ __forceinline__ void operator()(const f32x4 (&acc)[2][2][4][2], const Unit& u, int wr, int wc, int fr, int fq) const {
        const int row0 = u.pm * BM + wr * 64 + fr, col0 = u.pn * BM + wc * 32 + 8 * fq;
#pragma unroll
        for (int ai = 0; ai < 2; ++ai)
#pragma unroll
            for (int m = 0; m < 4; ++m) {
                const size_t off = (size_t)(row0 + ai * HALF + m * 16) * 1024 + col0;
#pragma unroll
                for (int bj = 0; bj < 2; ++bj) {
                    const u32x4 g = *(const u32x4*)(gate + off + bj * HALF);
                    f32x4 v0 = acc[ai][bj][m][0], v1 = acc[ai][bj][m][1];
                    v0[0] *= sigmoidf_(bf_lo(g.x)); v0[1] *= sigmoidf_(bf_hi(g.x)); v0[2] *= sigmoidf_(bf_lo(g.y)); v0[3] *= sigmoidf_(bf_hi(g.y));
                    v1[0] *= sigmoidf_(bf_lo(g.z)); v1[1] *= sigmoidf_(bf_hi(g.z)); v1[2] *= sigmoidf_(bf_lo(g.w)); v1[3] *= sigmoidf_(bf_hi(g.w));
                    *(f32x4*)(Y1 + off + bj * HALF) = v0; *(f32x4*)(Y1 + off + bj * HALF + 4) = v1;
                }
            }
    }
};
struct EpiGate2 {
    static constexpr bool PERM = true, AFTER_DRAIN = false;
    const bf16_t* gate; const float* Y1; bf16_t* Y;
    __device__ __forceinline__ void operator()(const f32x4 (&acc)[2][2][4][2], const Unit& u, int wr, int wc, int fr, int fq) const {
        const int row0 = u.pm * BM + wr * 64 + fr, col0 = u.pn * BM + wc * 32 + 8 * fq;
#pragma unroll
        for (int ai = 0; ai < 2; ++ai)
#pragma unroll
            for (int m = 0; m < 4; ++m) {
                const size_t off = (size_t)(row0 + ai * HALF + m * 16) * 1024 + col0;
#pragma unroll
                for (int bj = 0; bj < 2; ++bj) {
                    const u32x4 g = *(const u32x4*)(gate + off + bj * HALF);
                    const f32x4 y0 = *(const f32x4*)(Y1 + off + bj * HALF), y1 = *(const f32x4*)(Y1 + off + bj * HALF + 4);
                    f32x4 v0 = acc[ai][bj][m][0], v1 = acc[ai][bj][m][1];
                    v0[0] = y0[0] + v0[0] * sigmoidf_(bf_lo(g.x)); v0[1] = y0[1] + v0[1] * sigmoidf_(bf_hi(g.x)); v0[2] = y0[2] + v0[2] * sigmoidf_(bf_lo(g.y)); v0[3] = y0[3] + v0[3] * sigmoidf_(bf_hi(g.y));
                    v1[0] = y1[0] + v1[0] * sigmoidf_(bf_lo(g.z)); v1[1] = y1[1] + v1[1] * sigmoidf_(bf_hi(g.z)); v1[2] = y1[2] + v1[2] * sigmoidf_(bf_lo(g.w)); v1[3] = y1[3] + v1[3] * sigmoidf_(bf_hi(g.w));
                    u32x4 w; w.x = cvt_pk_bf16(v0[0], v0[1]); w.y = cvt_pk_bf16(v0[2], v0[3]); w.z = cvt_pk_bf16(v1[0], v1[1]); w.w = cvt_pk_bf16(v1[2], v1[3]);
                    *(u32x4*)(Y + off + bj * HALF) = w;
                }
            }
    }
};
struct EpiRes {
    static constexpr bool PERM = false, AFTER_DRAIN = false;
    const float* base; float* out; const float* gate;
    __device__ __forceinline__ void operator()(const f32x4 (&acc)[2][2][4][2], const Unit& u, int wr, int wc, int fr, int fq) const {
        const int row0 = u.pm * BM + wr * 64 + fr, col0 = u.pn * BM + wc * 32 + 4 * fq;
        const float* gp = gate + (size_t)((u.pm * BM) >> 13) * 6144 + col0;
        f32x4 gv[2][2];
#pragma unroll
        for (int bj = 0; bj < 2; ++bj)
#pragma unroll
            for (int n = 0; n < 2; ++n) gv[bj][n] = *(const f32x4*)(gp + bj * HALF + n * 16);
#pragma unroll
        for (int ai = 0; ai < 2; ++ai)
#pragma unroll
            for (int m = 0; m < 4; ++m) {
                const size_t off = (size_t)(row0 + ai * HALF + m * 16) * 1024 + col0;
#pragma unroll
                for (int bj = 0; bj < 2; ++bj)
#pragma unroll
                    for (int n = 0; n < 2; ++n) { const f32x4 bs = *(const f32x4*)(base + off + bj * HALF + n * 16);
                        *(f32x4*)(out + off + bj * HALF + n * 16) = bs + gv[bj][n] * acc[ai][bj][m][n]; }
            }
    }
};
struct EpiRelu2 {
    static constexpr bool PERM = true, AFTER_DRAIN = false;
    bf16_t* O; int ldc;
    __device__ __forceinline__ void operator()(const f32x4 (&acc)[2][2][4][2], const Unit& u, int wr, int wc, int fr, int fq) const {
        const int row0 = u.pm * BM + wr * 64 + fr, col0 = u.pn * BM + wc * 32 + 8 * fq;
#pragma unroll
        for (int ai = 0; ai < 2; ++ai)
#pragma unroll
            for (int m = 0; m < 4; ++m) {
                bf16_t* rowp = O + (size_t)(row0 + ai * HALF + m * 16) * ldc + col0;
#pragma unroll
                for (int bj = 0; bj < 2; ++bj) {
                    f32x4 v0 = acc[ai][bj][m][0], v1 = acc[ai][bj][m][1];
#pragma unroll
                    for (int j = 0; j < 4; ++j) { const float a = fmaxf(v0[j], 0.f), b = fmaxf(v1[j], 0.f); v0[j] = a * a; v1[j] = b * b; }
                    u32x4 w; w.x = cvt_pk_bf16(v0[0], v0[1]); w.y = cvt_pk_bf16(v0[2], v0[3]); w.z = cvt_pk_bf16(v1[0], v1[1]); w.w = cvt_pk_bf16(v1[2], v1[3]);
                    *(u32x4*)(rowp + bj * HALF) = w;
                }
            }
    }
};
template <class Epi, class Sched, bool ALIGN_EPI = false, bool SP2 = false>
__device__ __forceinline__ void gemm_phase(PG8_LAS unsigned char* lds, const Gemm g, const Sched& S, const Epi& E) {
    const int tid = fresh_tid(), wid = __builtin_amdgcn_readfirstlane(tid >> 6), lane = tid & 63, wr = wid >> 2, wc = wid & 3, fr = lane & 15, fq = lane >> 4;
    const int K = g.K, nt = K / BK;
    unsigned voffA[2], voffB[2];
#pragma unroll
    for (int i = 0; i < 2; ++i) { int R, C; stage_rc(tid * 16 + i * 8192, R, C); const int Rb = Epi::PERM ? ((R & ~31) + perm32(R & 31)) : R;
        voffA[i] = (unsigned)(R * K + C) * 2u; voffB[i] = (unsigned)(Rb * K + C) * 2u; }
    const size_t kstep = (size_t)(BK * 2);
    const size_t hstep = (size_t)HALF * K * 2;
    const size_t tstep = 2 * hstep;
    const unsigned ldsw = (unsigned)wid * 1024u;
    const int aoff = lds_byte(wr * 64 + fr, fq * 8), boff = lds_byte(wc * 32 + fr, fq * 8);
#define PG8_SA(b, h) (((b) * 2 + (h)) * HTB)
#define PG8_SB(b, h) ((4 + (b) * 2 + (h)) * HTB)
#define PG8_STAGE(bufoff, gbase, voff) do { _Pragma("unroll") for (int _i = 0; _i < 2; ++_i) \
        __builtin_amdgcn_global_load_lds((const unsigned*)((const char*)(gbase) + (voff)[_i]), (PG8_LAS unsigned*)(lds + (bufoff) + ldsw + _i * 8192), 16, 0, 0); } while (0)
#define PG8_LDA(dst, b, h) do { _Pragma("unroll") for (int m = 0; m < 4; ++m) _Pragma("unroll") for (int k = 0; k < 2; ++k) dst[m][k] = *(const PG8_LAS bf16x8*)(lds + PG8_SA(b, h) + aoff + m * 2048 + k * 1024); } while (0)
#define PG8_LDB(dst, b, h) do { _Pragma("unroll") for (int n = 0; n < 2; ++n) _Pragma("unroll") for (int k = 0; k < 2; ++k) dst[n][k] = *(const PG8_LAS bf16x8*)(lds + PG8_SB(b, h) + boff + n * 2048 + k * 1024); } while (0)
#define PG8_MMA(ai, bj, At, Bt) do { __builtin_amdgcn_s_setprio(1); _Pragma("unroll") for (int m = 0; m < 4; ++m) _Pragma("unroll") for (int n = 0; n < 2; ++n) _Pragma("unroll") for (int k = 0; k < 2; ++k) \
        acc[ai][bj][m][n] = __builtin_amdgcn_mfma_f32_16x16x32_bf16(Bt[n][k], At[m][k], acc[ai][bj][m][n], 0, 0, 0); __builtin_amdgcn_s_setprio(0); } while (0)
#define PG8_WAIT_V(n) asm volatile("s_waitcnt vmcnt(" #n ")" ::: "memory")
#define PG8_WAIT_L(n) asm volatile("s_waitcnt lgkmcnt(" #n ")" ::: "memory")
#define PG8_BAR __builtin_amdgcn_s_barrier()
#define PG8_SCHED __builtin_amdgcn_sched_barrier(0)
    Unit cur, nxt; int ui = 0;
    if (!S.next(0, cur)) return;
    f32x4 acc[2][2][4][2];
#pragma unroll
    for (int a = 0; a < 2; ++a)
#pragma unroll
        for (int b = 0; b < 2; ++b)
#pragma unroll
            for (int m = 0; m < 4; ++m)
#pragma unroll
                for (int n = 0; n < 2; ++n) acc[a][b][m][n] = (f32x4){0.f, 0.f, 0.f, 0.f};
    bf16x8 At[4][2], B0[2][2], B1[2][2];
    const char* cA = (const char*)g.A + (size_t)cur.pm * tstep; const char* cB = (const char*)g.Bt + (size_t)cur.pn * tstep;
    S.a_ready(cur);
    if constexpr (SP2) {
        PG8_STAGE(PG8_SB(0, 0), cB, voffB); PG8_STAGE(PG8_SB(0, 1), cB + hstep, voffB); PG8_STAGE(PG8_SA(0, 0), cA, voffA); PG8_STAGE(PG8_SA(0, 1), cA + hstep, voffA);
        if (wr == 1) PG8_BAR;
        PG8_WAIT_V(2); PG8_BAR;
        PG8_STAGE(PG8_SB(1, 0), cB + kstep, voffB); PG8_STAGE(PG8_SA(1, 0), cA + kstep, voffA); PG8_STAGE(PG8_SB(1, 1), cB + hstep + kstep, voffB);
        PG8_WAIT_V(6); PG8_BAR;
    } else {
        PG8_STAGE(PG8_SB(0, 0), cB, voffB); PG8_STAGE(PG8_SA(0, 0), cA, voffA); PG8_STAGE(PG8_SB(0, 1), cB + hstep, voffB); PG8_STAGE(PG8_SA(0, 1), cA + hstep, voffA);
        if (wr == 1) PG8_BAR;
        PG8_WAIT_V(4); PG8_BAR;
        PG8_STAGE(PG8_SB(1, 0), cB + kstep, voffB); PG8_STAGE(PG8_SA(1, 0), cA + kstep, voffA); PG8_STAGE(PG8_SB(1, 1), cB + hstep + kstep, voffB);
        PG8_WAIT_V(6); PG8_BAR;
    }
    for (;;) {
        const bool has_next = S.next(ui + 1, nxt);
        const char* nA = has_next ? (const char*)g.A + (size_t)nxt.pm * tstep : cA; const char* nB = has_next ? (const char*)g.Bt + (size_t)nxt.pn * tstep : cB;
        for (int t = 0; t < nt; t += 2) {
            const bool last = (t == nt - 2);
            const char* a1 = cA + (size_t)(t + 1) * kstep;
            const char* a2 = last ? nA : cA + (size_t)(t + 2) * kstep; const char* b2 = last ? nB : cB + (size_t)(t + 2) * kstep;
            const char* a3 = a2 + kstep; const char* b3 = b2 + kstep;
            if (last && has_next) S.a_ready(nxt);
            if constexpr (SP2) {
            PG8_LDB(B0, 0, 0); PG8_LDB(B1, 0, 1); PG8_SCHED; PG8_LDA(At, 0, 0); PG8_STAGE(PG8_SA(1, 1), a1 + hstep, voffA);
            PG8_WAIT_V(8); PG8_WAIT_L(0); PG8_BAR; PG8_MMA(0, 0, At, B0); PG8_MMA(0, 1, At, B1); PG8_BAR; PG8_SCHED;
            PG8_LDA(At, 0, 1); PG8_STAGE(PG8_SB(0, 0), b2, voffB); PG8_STAGE(PG8_SB(0, 1), b2 + hstep, voffB); PG8_STAGE(PG8_SA(0, 0), a2, voffA);
            PG8_WAIT_V(8); PG8_WAIT_L(0); PG8_BAR; PG8_MMA(1, 0, At, B0); PG8_MMA(1, 1, At, B1); PG8_BAR; PG8_SCHED;
            PG8_LDB(B0, 1, 0); PG8_LDB(B1, 1, 1); PG8_SCHED; PG8_LDA(At, 1, 0); PG8_STAGE(PG8_SA(0, 1), a2 + hstep, voffA);
            PG8_WAIT_V(8); PG8_WAIT_L(0); PG8_BAR; PG8_MMA(0, 0, At, B0); PG8_MMA(0, 1, At, B1); PG8_BAR; PG8_SCHED;
            PG8_LDA(At, 1, 1); PG8_STAGE(PG8_SB(1, 0), b3, voffB); PG8_STAGE(PG8_SB(1, 1), b3 + hstep, voffB); PG8_STAGE(PG8_SA(1, 0), a3, voffA);
            PG8_WAIT_V(8); PG8_WAIT_L(0); PG8_BAR; PG8_MMA(1, 0, At, B0); PG8_MMA(1, 1, At, B1); PG8_BAR; PG8_SCHED;
            } else {
            PG8_LDB(B0, 0, 0); PG8_SCHED; PG8_LDA(At, 0, 0); PG8_STAGE(PG8_SA(1, 1), a1 + hstep, voffA);
            PG8_WAIT_L(8); PG8_BAR; PG8_WAIT_L(0); PG8_MMA(0, 0, At, B0); PG8_BAR; PG8_SCHED;
            PG8_LDB(B1, 0, 1); PG8_STAGE(PG8_SB(0, 0), b2, voffB);
            PG8_BAR; PG8_WAIT_L(0); PG8_MMA(0, 1, At, B1); PG8_BAR;
            PG8_LDA(At, 0, 1); PG8_STAGE(PG8_SA(0, 0), a2, voffA);
            PG8_BAR; PG8_WAIT_L(0); PG8_MMA(1, 0, At, B0); PG8_BAR; PG8_SCHED;
            PG8_STAGE(PG8_SB(0, 1), b2 + hstep, voffB);
            PG8_WAIT_V(6); PG8_BAR; PG8_MMA(1, 1, At, B1); PG8_BAR;
            PG8_LDB(B0, 1, 0); PG8_SCHED; PG8_LDA(At, 1, 0); PG8_STAGE(PG8_SA(0, 1), a2 + hstep, voffA);
            PG8_WAIT_L(8); PG8_BAR; PG8_WAIT_L(0); PG8_MMA(0, 0, At, B0); PG8_BAR; PG8_SCHED;
            PG8_LDB(B1, 1, 1); PG8_STAGE(PG8_SB(1, 0), b3, voffB);
            PG8_BAR; PG8_WAIT_L(0); PG8_MMA(0, 1, At, B1); PG8_BAR;
            PG8_LDA(At, 1, 1); PG8_STAGE(PG8_SA(1, 0), a3, voffA);
            PG8_BAR; PG8_WAIT_L(0); PG8_MMA(1, 0, At, B0); PG8_BAR; PG8_SCHED;
            PG8_STAGE(PG8_SB(1, 1), b3 + hstep, voffB);
            PG8_WAIT_V(6); PG8_BAR; PG8_MMA(1, 1, At, B1); PG8_BAR;
            }
        }
        if constexpr (ALIGN_EPI) { if (wr == 0) PG8_BAR; }
        if constexpr (!Epi::AFTER_DRAIN) { E(acc, cur, wr, wc, fr, fq); S.done(cur); }
        if (!has_next) break;
#pragma unroll
        for (int a = 0; a < 2; ++a)
#pragma unroll
            for (int b = 0; b < 2; ++b)
#pragma unroll
                for (int m = 0; m < 4; ++m)
#pragma unroll
                    for (int n = 0; n < 2; ++n) acc[a][b][m][n] = (f32x4){0.f, 0.f, 0.f, 0.f};
        cur = nxt; cA = nA; cB = nB; ++ui;
        if constexpr (ALIGN_EPI) { if (wr == 1) PG8_BAR; }
    }
    PG8_WAIT_V(0);
    if constexpr (!ALIGN_EPI) { if (wr == 0) PG8_BAR; }
    PG8_BAR;
    if constexpr (Epi::AFTER_DRAIN) { E.fused(acc, cur, wr, wc, fr, fq, lds, wid, lane); S.done(cur); }
#undef PG8_SA
#undef PG8_SB
#undef PG8_STAGE
#undef PG8_LDA
#undef PG8_LDB
#undef PG8_MMA
#undef PG8_WAIT_V
#undef PG8_WAIT_L
#undef PG8_BAR
#undef PG8_SCHED
}
}
#include <hip/hip_bf16.h>
#include <cmath>
namespace attn_body {
using bf16=__hip_bfloat16;
using bf16x8=__attribute__((ext_vector_type(8)))short;
using s16x4=__attribute__((ext_vector_type(4)))short;
using f32x16=__attribute__((ext_vector_type(16)))float;
using u32x4=__attribute__((ext_vector_type(4)))unsigned;
constexpr int BATCH=2,NHEAD=16,SEQ=8192,D=64,DM=NHEAD*D;
constexpr int NW=8,QBLK=32,QB=QBLK*NW,KVBLK=64,NQB=SEQ/QB;
constexpr int ATTN_PITCH=DM, ATTN_UNIT_ROWS=QB;
__device__ __forceinline__ int crow(int r,int hi){return (r&3)+8*(r>>2)+4*hi;}
#define SBAR() __builtin_amdgcn_sched_barrier(0)
__device__ __forceinline__ void cmask(f32x16&p0,f32x16&p1,int jb,int qrel,int hi){
  const float NEG=-INFINITY; int kb=64*jb+4*hi;
  #pragma unroll
  for(int r=0;r<16;++r){int kv=kb+(r&3)+8*(r>>2); if(kv>qrel)p0[r]=NEG; if(kv+32>qrel)p1[r]=NEG;}
}

constexpr int NSLOT=3, SLOTB=8192;
constexpr int LDS_K=0, LDS_V=NSLOT*SLOTB, LDS_WS=2*NSLOT*SLOTB, LDS_OST=LDS_WS+NW*64*4, LDS_BYTES=LDS_OST+NW*4096;
constexpr float C2=0.125f*1.4426950408889634f;
__device__ __forceinline__ void glds16(const void*gsrc,unsigned lds_dst){unsigned keep;
  asm volatile("s_mov_b32 %0, m0\n\ts_mov_b32 m0, %2\n\ts_nop 0\n\tglobal_load_lds_dwordx4 %1, off\n\ts_mov_b32 m0, %0":"=&s"(keep):"v"(gsrc),"s"(lds_dst):"memory");}
__device__ __forceinline__ float max3f(float a,float b,float c){float r;asm("v_max3_f32 %0, %1, %2, %3":"=v"(r):"v"(a),"v"(b),"v"(c));return r;}
__device__ __forceinline__ float max2f(float a,float b){float r;asm("v_max_f32_e32 %0, %1, %2":"=v"(r):"v"(a),"v"(b));return r;}
__device__ __forceinline__ float fadd_s(float a,float b){float r;asm("v_add_f32_e32 %0, %1, %2":"=v"(r):"v"(a),"v"(b));return r;}
__device__ __forceinline__ float fsub_s(float a,float b){float r;asm("v_sub_f32_e32 %0, %1, %2":"=v"(r):"v"(a),"v"(b));return r;}
typedef float f32x2_t __attribute__((ext_vector_type(2))); typedef __bf16 bf16x2_t __attribute__((ext_vector_type(2)));
__device__ __forceinline__ unsigned cvtpk_s(float lo,float hi){f32x2_t v={lo,hi};bf16x2_t b=__builtin_convertvector(v,bf16x2_t);return __builtin_bit_cast(unsigned,b);}
#define WAIT_BAR(N) asm volatile("s_waitcnt vmcnt(" #N ") lgkmcnt(0)\n\ts_barrier":::"memory")

__device__ __forceinline__ void qkt(f32x16&p0,f32x16&p1,const char*Kslot,const bf16x8*qr,const f32x16&negm,int r32,int hi){
  const char*kb=Kslot+hi*1024+r32*16;
  #pragma unroll
  for(int d0=0;d0<4;++d0){
    const bf16x8 b0=*reinterpret_cast<const bf16x8*>(kb+d0*2048);
    const bf16x8 b1=*reinterpret_cast<const bf16x8*>(kb+d0*2048+512);
    if(d0==0){p0=__builtin_amdgcn_mfma_f32_32x32x16_bf16(b0,qr[0],negm,0,0,0);p1=__builtin_amdgcn_mfma_f32_32x32x16_bf16(b1,qr[0],negm,0,0,0);}
    else{p0=__builtin_amdgcn_mfma_f32_32x32x16_bf16(b0,qr[d0],p0,0,0,0);p1=__builtin_amdgcn_mfma_f32_32x32x16_bf16(b1,qr[d0],p1,0,0,0);}}
}
typedef __attribute__((address_space(3))) const char* lds_cptr;
typedef short v4i16_t __attribute__((ext_vector_type(4)));
__device__ __forceinline__ void kload8(bf16x8*kf,lds_cptr kp){
  kf[0]=*(const __attribute__((address_space(3))) bf16x8*)(kp);      kf[1]=*(const __attribute__((address_space(3))) bf16x8*)(kp+512);
  kf[2]=*(const __attribute__((address_space(3))) bf16x8*)(kp+2048); kf[3]=*(const __attribute__((address_space(3))) bf16x8*)(kp+2560);
  kf[4]=*(const __attribute__((address_space(3))) bf16x8*)(kp+4096); kf[5]=*(const __attribute__((address_space(3))) bf16x8*)(kp+4608);
  kf[6]=*(const __attribute__((address_space(3))) bf16x8*)(kp+6144); kf[7]=*(const __attribute__((address_space(3))) bf16x8*)(kp+6656);
}
__device__ __forceinline__ void kload2(bf16x8*kf,lds_cptr kp,int j){ kf[2*j]=*(const __attribute__((address_space(3))) bf16x8*)(kp+j*2048); kf[2*j+1]=*(const __attribute__((address_space(3))) bf16x8*)(kp+j*2048+512); }
__device__ __forceinline__ s16x4 vtr(lds_cptr p){ return __builtin_bit_cast(s16x4,__builtin_amdgcn_ds_read_tr16_b64_v4i16((__attribute__((address_space(3))) v4i16_t*)p)); }
__device__ __forceinline__ float rowmax(const f32x16&p0,const f32x16&p1){
  float a=max3f(p0[0],p0[1],p1[0]),b=max3f(p0[2],p0[3],p1[1]);a=max3f(a,p1[2],p1[3]);
  #pragma unroll
  for(int r=4;r<16;r+=4){a=max3f(a,p0[r],p0[r+1]);b=max3f(b,p0[r+2],p0[r+3]);a=max3f(a,p1[r],p1[r+1]);b=max3f(b,p1[r+2],p1[r+3]);}
  const float m=max2f(a,b);
  auto rr=__builtin_amdgcn_permlane32_swap(__float_as_uint(m),__float_as_uint(m),false,false);
  return max2f(__uint_as_float(rr[0]),__uint_as_float(rr[1]));
}
__device__ __forceinline__ void pv(f32x16*o,int vb,bf16x8 pa0,bf16x8 pa1,bf16x8 pa2,bf16x8 pa3){
  #pragma unroll
  for(int d0=0;d0<2;++d0){s16x4 lo[4],hi[4];
    #pragma unroll
    for(int ks=0;ks<4;++ks){
      asm volatile("ds_read_b64_tr_b16 %0,%1 offset:%c2":"=&v"(lo[ks]):"v"(vb),"i"(d0*4096+ks*1024):"memory");
      asm volatile("ds_read_b64_tr_b16 %0,%1 offset:%c2":"=&v"(hi[ks]):"v"(vb),"i"(d0*4096+ks*1024+512):"memory");}
    asm volatile("s_waitcnt lgkmcnt(0)":::"memory");SBAR();
    #define PK(k) (bf16x8){lo[k][0],lo[k][1],lo[k][2],lo[k][3],hi[k][0],hi[k][1],hi[k][2],hi[k][3]}
    o[d0]=__builtin_amdgcn_mfma_f32_32x32x16_bf16(pa0,PK(0),o[d0],0,0,0);
    o[d0]=__builtin_amdgcn_mfma_f32_32x32x16_bf16(pa1,PK(1),o[d0],0,0,0);
    o[d0]=__builtin_amdgcn_mfma_f32_32x32x16_bf16(pa2,PK(2),o[d0],0,0,0);
    o[d0]=__builtin_amdgcn_mfma_f32_32x32x16_bf16(pa3,PK(3),o[d0],0,0,0);
    #undef PK
  }
}

#ifndef ATTN_STORE16
#define ATTN_STORE16(p,v) (*(u32x4*)(p)=(v))
#endif
template<int THRL> __device__ __forceinline__ void attn_unit(int b,int h,int hv,int qb,const bf16*Q,const bf16*__restrict__ K,const bf16*__restrict__ V,bf16*O,char*shm){
  const int tid=fresh_tid(),lane=tid&63,r32=lane&31,hi=lane>>5; const int wid=__builtin_amdgcn_readfirstlane(tid>>6);
  const long rowbase=(long)b*SEQ; const int q0=qb*QB;
  const bf16*Qw=Q+(rowbase+q0+wid*QBLK)*DM+h*D;
  const bf16*Kh=K+rowbase*DM+h*D,*Vh=V+rowbase*DM+hv*D;
  const unsigned lds0=(unsigned)(uintptr_t)shm;
  float*wsf=(float*)(shm+LDS_WS)+wid*64;
  const bf16*ksrc=Kh+(long)lane*DM+wid*8;
  const bf16*vsrc=Vh+(long)(16*(wid&3)+(lane>>2))*DM+(wid>>2)*32+(lane&3)*8;
  const unsigned kdst=lds0+LDS_K+wid*1024, vdst=lds0+LDS_V+wid*1024;
  #define DMA_K(t,slot) glds16(ksrc+(long)(t)*KVBLK*DM,(unsigned)__builtin_amdgcn_readfirstlane(kdst+(slot)))
  #define DMA_V(t,slot) glds16(vsrc+(long)(t)*KVBLK*DM,(unsigned)__builtin_amdgcn_readfirstlane(vdst+(slot)))
  const int vb0=(int)(lds0+LDS_V)+((lane>>4)&1)*32+(lane&3)*8+(4*hi+((lane&15)>>2))*64;
  const char*Kbase=shm+LDS_K; bf16x8 kf[8];
  const lds_cptr shm3=(lds_cptr)shm; const lds_cptr kp0=shm3+LDS_K+hi*1024+r32*16; const lds_cptr vp0=shm3+LDS_V+((lane>>4)&1)*32+(lane&3)*8+(4*hi+((lane&15)>>2))*64;
  const int NT=(q0+QB)/KVBLK;
  DMA_K(0,0);DMA_V(0,0);DMA_K(1,SLOTB);
  bf16x8 qr[4];
  #pragma unroll
  for(int d0=0;d0<4;++d0)qr[d0]=*reinterpret_cast<const bf16x8*>(&Qw[(long)r32*DM+d0*16+hi*8]);
  float mhat=0.f,l_reg=0.f;f32x16 o[2];o[0]=f32x16{};o[1]=f32x16{};f32x16 negm=f32x16{};asm volatile("":"+v"(negm));
  const int qrel=wid*QBLK+r32;
  #define CMASK(P0,P1,t) do{int jb_=(t)-(NT-4); if(jb_>=0)cmask(P0,P1,jb_,qrel,hi);}while(0)
  bool resc=false;
  #define START(P0,P1) do{ const float rm=rowmax(P0,P1); resc=false; \
    { const float dl=rm; mhat=fadd_s(mhat,dl); \
      _Pragma("unroll") for(int r=0;r<16;++r){P0[r]=fsub_s(P0[r],dl);P1[r]=fsub_s(P1[r],dl);} \
      _Pragma("unroll") for(int r=0;r<16;++r)negm[r]=-mhat; asm volatile("":"+v"(negm)); } \
    _Pragma("unroll") for(int r=0;r<16;++r)P0[r]=__builtin_amdgcn_exp2f(P0[r]); }while(0)
  #define RESC() do{ if(resc){ asm volatile("s_waitcnt lgkmcnt(0)":::"memory"); \
      _Pragma("unroll") for(int d_=0;d_<2;++d_) _Pragma("unroll") for(int r=0;r<16;++r)o[d_][r]*=wsf[crow(r,hi)]; } }while(0)
  f32x16 pA0,pA1,pB0,pB1;
  int sl_prev=0,sl_cur=0,sl_next=SLOTB;
  #define ROT() do{sl_prev=sl_cur;sl_cur=sl_next;sl_next=(sl_next==(NSLOT-1)*SLOTB)?0:sl_next+SLOTB;}while(0)
  DMA_K(2,2*SLOTB);
  WAIT_BAR(3);
  qkt(pA0,pA1,Kbase,qr,negm,r32,hi);asm volatile("s_nop 15\n\ts_nop 7":"+v"(pA0),"+v"(pA1));CMASK(pA0,pA1,0);
  START(pA0,pA1);
  _Pragma("unroll") for(int r=0;r<16;++r)pA1[r]=__builtin_amdgcn_exp2f(pA1[r]);
  WAIT_BAR(0);
  DMA_K(3,0);DMA_V(1,SLOTB);
  ROT();
  kload8(kf,kp0+sl_cur);
  WAIT_BAR(2);
  s16x4 vlo[8],vhi[8]; u32x4 pw0,pw1,pw2,pw3;
  #define PKW(P,B) cvtpk_s(P[B],P[B+1])
  #define PAF(k) __builtin_bit_cast(bf16x8,pw##k)
  #define VFR(i) (bf16x8){vlo[i][0],vlo[i][1],vlo[i][2],vlo[i][3],vhi[i][0],vhi[i][1],vhi[i][2],vhi[i][3]}
  #define PIN(x) asm volatile("":"+v"(x))
  #define MX3(a,b,c) __builtin_fmaxf(__builtin_fmaxf((a),(b)),(c))
  #define GAPA(MF,A0,A1,A2,A3,W0,W1,PW) do{ MF; sacc+=A0; sacc+=A1; sacc+=A2; sacc+=A3; PIN(sacc); W0; W1; PIN(PW); SBAR(); }while(0)
  #define EX(v) __builtin_amdgcn_exp2f(v)
  #define GAPB(MF,X,B) do{ MF; X[B]=EX(X[B]); X[B+1]=EX(X[B+1]); X[B+2]=EX(X[B+2]); X[B+3]=EX(X[B+3]); PIN(X); SBAR(); }while(0)
  #define VRD(i) do{ vlo[i]=vtr(vp_+(((i)>>2)*4096+((i)&3)*1024)); vhi[i]=vtr(vp_+(((i)>>2)*4096+((i)&3)*1024+512)); }while(0)
  #define KRD(G,j) do{ if(G){ kload2(kf,kp0+sl_next,j); SBAR(); } }while(0)
  #define STEP(C0,C1,P0,P1,t,GK,GV,GL) do{ SBAR(); \
    const lds_cptr vp_=vp0+sl_prev; \
    VRD(0); SBAR(); float sacc=(P0[0]+P0[1]); \
    GAPA(C0=__builtin_amdgcn_mfma_f32_32x32x16_bf16(kf[0],qr[0],negm,0,0,0), P0[2],P0[3],P0[4],P0[5],     pw0[0]=PKW(P0,0), pw0[1]=PKW(P0,2), pw0); \
    VRD(4); SBAR(); GAPA(C1=__builtin_amdgcn_mfma_f32_32x32x16_bf16(kf[1],qr[0],negm,0,0,0), P0[6],P0[7],P0[8],P0[9],     pw0[2]=PKW(P0,4), pw0[3]=PKW(P0,6), pw0); \
    VRD(1); SBAR(); GAPA(C0=__builtin_amdgcn_mfma_f32_32x32x16_bf16(kf[2],qr[1],C0,0,0,0),   P0[10],P0[11],P0[12],P0[13], pw1[0]=PKW(P0,8), pw1[1]=PKW(P0,10), pw1); \
    VRD(5); SBAR(); GAPA(C1=__builtin_amdgcn_mfma_f32_32x32x16_bf16(kf[3],qr[1],C1,0,0,0),   P0[14],P0[15],P1[0],P1[1],   pw1[2]=PKW(P0,12),pw1[3]=PKW(P0,14), pw1); \
    VRD(2); SBAR(); GAPA(C0=__builtin_amdgcn_mfma_f32_32x32x16_bf16(kf[4],qr[2],C0,0,0,0),   P1[2],P1[3],P1[4],P1[5],     pw2[0]=PKW(P1,0), pw2[1]=PKW(P1,2), pw2); \
    VRD(6); SBAR(); GAPA(C1=__builtin_amdgcn_mfma_f32_32x32x16_bf16(kf[5],qr[2],C1,0,0,0),   P1[6],P1[7],P1[8],P1[9],     pw2[2]=PKW(P1,4), pw2[3]=PKW(P1,6), pw2); \
    VRD(3); SBAR(); GAPA(C0=__builtin_amdgcn_mfma_f32_32x32x16_bf16(kf[6],qr[3],C0,0,0,0),   P1[10],P1[11],P1[12],P1[13], pw3[0]=PKW(P1,8), pw3[1]=PKW(P1,10), pw3); \
    VRD(7); SBAR(); GAPA(C1=__builtin_amdgcn_mfma_f32_32x32x16_bf16(kf[7],qr[3],C1,0,0,0),   P1[14],P1[15],0.f,0.f,       pw3[2]=PKW(P1,12),pw3[3]=PKW(P1,14), pw3); \
    l_reg+=sacc; \
    if(GK){DMA_K((t)+3,sl_cur);} if(GV){DMA_V((t)+1,sl_next);} \
    CMASK(C0,C1,t); \
    { float a=MX3(C0[0],C0[1],C1[0]),b=MX3(C0[2],C0[3],C1[1]); a=MX3(a,C1[2],C1[3]); \
      _Pragma("unroll") for(int r=4;r<16;r+=4){a=MX3(a,C0[r],C0[r+1]);b=MX3(b,C0[r+2],C0[r+3]);a=MX3(a,C1[r],C1[r+1]);b=MX3(b,C1[r+2],C1[r+3]);} \
      float rm=__builtin_fmaxf(a,b); { auto rr=__builtin_amdgcn_permlane32_swap(__float_as_uint(rm),__float_as_uint(rm),false,false); rm=__builtin_fmaxf(__uint_as_float(rr[0]),__uint_as_float(rr[1])); } \
      resc=false; \
      if(__builtin_expect(__any(rm>(float)THRL),0)){ const float dl=__builtin_fmaxf(rm,0.f); mhat+=dl; \
        _Pragma("unroll") for(int r=0;r<16;++r){C0[r]-=dl;C1[r]-=dl;} \
        _Pragma("unroll") for(int r=0;r<16;++r)negm[r]=-mhat; asm volatile("":"+v"(negm)); \
        const float f=__builtin_amdgcn_exp2f(-dl); l_reg*=f; if(hi==0)wsf[r32]=f; resc=true; } } \
    SBAR(); \
    GAPB(o[0]=__builtin_amdgcn_mfma_f32_32x32x16_bf16(PAF(0),VFR(0),o[0],0,0,0), C0,0); \
    GAPB(o[1]=__builtin_amdgcn_mfma_f32_32x32x16_bf16(PAF(0),VFR(4),o[1],0,0,0), C0,4); \
    KRD(GL,0); GAPB(o[0]=__builtin_amdgcn_mfma_f32_32x32x16_bf16(PAF(1),VFR(1),o[0],0,0,0), C0,8); \
    KRD(GL,1); GAPB(o[1]=__builtin_amdgcn_mfma_f32_32x32x16_bf16(PAF(1),VFR(5),o[1],0,0,0), C0,12); \
    KRD(GL,2); GAPB(o[0]=__builtin_amdgcn_mfma_f32_32x32x16_bf16(PAF(2),VFR(2),o[0],0,0,0), C1,0); \
    KRD(GL,3); GAPB(o[1]=__builtin_amdgcn_mfma_f32_32x32x16_bf16(PAF(2),VFR(6),o[1],0,0,0), C1,4); \
    GAPB(o[0]=__builtin_amdgcn_mfma_f32_32x32x16_bf16(PAF(3),VFR(3),o[0],0,0,0), C1,8); \
    GAPB(o[1]=__builtin_amdgcn_mfma_f32_32x32x16_bf16(PAF(3),VFR(7),o[1],0,0,0), C1,12); \
    }while(0)
  int t=1;
  #undef CMASK
  #define CMASK(P0,P1,t) do{}while(0)
  for(;t+5<NT;t+=2){
    STEP(pB0,pB1,pA0,pA1,t,true,true,true);     WAIT_BAR(2); RESC(); ROT();
    STEP(pA0,pA1,pB0,pB1,t+1,true,true,true);   WAIT_BAR(2); RESC(); ROT();
  }
  #undef CMASK
  #define CMASK(P0,P1,t) do{int jb_=(t)-(NT-4); if(jb_>=0)cmask(P0,P1,jb_,qrel,hi);}while(0)
  #define ENDW(tt) do{ if((tt)+3<NT){WAIT_BAR(2);} else if((tt)+2<NT){WAIT_BAR(1);} else {WAIT_BAR(0);} }while(0)
  for(;t+1<NT;t+=2){
    STEP(pB0,pB1,pA0,pA1,t,(t+3<NT),(t+1<NT),(t+1<NT));       ENDW(t);   RESC(); ROT();
    STEP(pA0,pA1,pB0,pB1,t+1,(t+4<NT),(t+2<NT),(t+2<NT));     ENDW(t+1); RESC(); ROT();
  }
  STEP(pB0,pB1,pA0,pA1,NT-1,false,false,false); RESC();
  { float sacc=pB0[0]+pB0[1]; _Pragma("unroll") for(int r=2;r<16;++r)sacc+=pB0[r]; _Pragma("unroll") for(int r=0;r<16;++r)sacc+=pB1[r]; l_reg+=sacc;
    pw0=(u32x4){PKW(pB0,0),PKW(pB0,2),PKW(pB0,4),PKW(pB0,6)};pw1=(u32x4){PKW(pB0,8),PKW(pB0,10),PKW(pB0,12),PKW(pB0,14)};pw2=(u32x4){PKW(pB1,0),PKW(pB1,2),PKW(pB1,4),PKW(pB1,6)};pw3=(u32x4){PKW(pB1,8),PKW(pB1,10),PKW(pB1,12),PKW(pB1,14)};
    SBAR(); pv(o,vb0+sl_cur,PAF(0),PAF(1),PAF(2),PAF(3)); }
  #undef PKW
  #undef PAF
  #undef VFR
  #undef PIN
  #undef MX3
  #undef GAPA
  #undef GAPB
  #undef EX
  #undef VRD
  #undef KRD
  #undef STEP
  #undef ENDW
  {auto rr=__builtin_amdgcn_permlane32_swap(__float_as_uint(l_reg),__float_as_uint(l_reg),false,false);l_reg=__uint_as_float(rr[0])+__uint_as_float(rr[1]);}
  if(hi==0)wsf[32+r32]=l_reg;asm volatile("s_waitcnt lgkmcnt(0)":::"memory");
  float rli[16];
  #pragma unroll
  for(int r=0;r<16;++r)rli[r]=__builtin_amdgcn_rcpf(wsf[32+crow(r,hi)]);
  bf16*Ow=O+(rowbase+q0+wid*QBLK)*DM+hv*D;
  { bf16*stg=(bf16*)(shm+LDS_OST)+wid*2048;
    #pragma unroll
    for(int r=0;r<16;++r){const int orow=crow(r,hi);
      #pragma unroll
      for(int d0=0;d0<2;++d0)stg[orow*64+d0*32+r32]=__float2bfloat16(o[d0][r]*rli[r]);}
    asm volatile("s_waitcnt lgkmcnt(0)":::"memory");
    #pragma unroll
    for(int i=0;i<4;++i){const int row=i*8+(lane>>3),ch=lane&7; const u32x4 v=*(const u32x4*)(stg+row*64+ch*8); ATTN_STORE16(Ow+(long)row*DM+ch*8,v);} }
  asm volatile("s_waitcnt lgkmcnt(0)\n\ts_barrier":::"memory");
  #undef DMA_K
  #undef DMA_V
  #undef CMASK
  #undef START
  #undef RESC
  #undef ROT
}
constexpr int ATTN_LDS_BYTES=LDS_BYTES;
#undef SBAR
#undef WAIT_BAR
}
#define LAS __attribute__((address_space(3)))
typedef unsigned short bf16;
typedef unsigned v4u __attribute__((ext_vector_type(4)));
typedef float f32x4 __attribute__((ext_vector_type(4)));
typedef float f32x16 __attribute__((ext_vector_type(16)));
typedef short bf16x8 __attribute__((ext_vector_type(8)));
constexpr int NWAVES = 8, NTHR = 512;
constexpr int NB = 4, SEQ = 8192, DM = 1024, TT = NB * SEQ, TH = 16384, FF = 4096, NIN = 9216;
constexpr float EPS = 1e-6f;
constexpr size_t MiB = 1u << 20;
constexpr size_t WS_ADA = 0, WS_ROPE = 1 * MiB, WS_BAR = 3 * MiB, WS_WIN = 4 * MiB, WS_WPA = 22 * MiB, WS_WPR = 24 * MiB, WS_WOUT = 26 * MiB, WS_W1 = 28 * MiB, WS_W2 = 36 * MiB;
constexpr size_t WS_XN = 44 * MiB, WS_Y = 108 * MiB, WS_P = 172 * MiB, WS_DEC = 460 * MiB, WS_END = 462 * MiB;
constexpr size_t PBUF = (size_t)TH * 1024;
constexpr size_t DO_O0 = 0, DO_O1 = 32 * MiB, DO_UST = 64 * MiB;
constexpr int LDS_BYTES = 147456;

#define LDS_WAIT() asm volatile("s_waitcnt lgkmcnt(0)" ::: "memory")
__device__ __forceinline__ unsigned f2bf(float f) { unsigned u = __builtin_bit_cast(unsigned, f); return (u + 0x7fffu + ((u >> 16) & 1u)) >> 16; }
__device__ __forceinline__ unsigned pk2(float lo, float hi) { return f2bf(lo) | (f2bf(hi) << 16); }
__device__ __forceinline__ float bflo(unsigned w) { return __uint_as_float(w << 16); }
__device__ __forceinline__ float bfhi(unsigned w) { return __uint_as_float(w & 0xffff0000u); }
__device__ __forceinline__ float wave_sum(float v) {
#pragma unroll
    for (int o = 1; o < 64; o <<= 1) v += __shfl_xor(v, o);
    return v;
}
struct Args { const float* in[21]; const int* pos; float* out; unsigned char* ws; };

__device__ __forceinline__ void p0_transpose_item(const float* W, int K, int N, bf16* WT, LAS float* scr, int item, int lane) {
    const int nblk = N / 32, kb = item / nblk, nb = item % nblk, k0 = 64 * kb, n0 = 32 * nb;
#pragma unroll 8
    for (int i = 0; i < 32; ++i) { const int kk = 2 * i + (lane >> 5); scr[kk * 33 + (lane & 31)] = W[(size_t)(k0 + kk) * N + n0 + (lane & 31)]; }
    LDS_WAIT(); asm volatile("" ::: "memory");
    const int c = lane & 7;
#pragma unroll
    for (int j = 0; j < 4; ++j) { const int n = (lane >> 3) + 8 * j; const LAS float* s = scr + (8 * c) * 33 + n;
        v4u o; o.x = pk2(s[0 * 33], s[1 * 33]); o.y = pk2(s[2 * 33], s[3 * 33]); o.z = pk2(s[4 * 33], s[5 * 33]); o.w = pk2(s[6 * 33], s[7 * 33]);
        *(v4u*)(WT + (size_t)(n0 + n) * K + k0 + 8 * c) = o; }
    LDS_WAIT(); asm volatile("" ::: "memory");
}

__device__ __forceinline__ void norm_mod_row(const float* xrow, const float* w, const float* sc, const float* sh, bf16* orow, int lane) {
    const f32x4* xr = (const f32x4*)xrow + lane;
    f32x4 v[4]; float s = 0.f;
#pragma unroll
    for (int j = 0; j < 4; ++j) { v[j] = xr[64 * j]; s += (v[j].x * v[j].x + v[j].y * v[j].y) + (v[j].z * v[j].z + v[j].w * v[j].w); }
    const float rinv = 1.0f / sqrtf(wave_sum(s) * (1.f / 1024.f) + EPS);
    unsigned long long* o8 = (unsigned long long*)orow + lane;
#pragma unroll
    for (int j = 0; j < 4; ++j) {
        const f32x4 wv = ((const f32x4*)w)[lane + 64 * j], scv = ((const f32x4*)sc)[lane + 64 * j], shv = ((const f32x4*)sh)[lane + 64 * j];
        const f32x4 o = v[j] * rinv * wv * (scv + 1.0f) + shv;
        o8[64 * j] = (unsigned long long)pk2(o.x, o.y) | ((unsigned long long)pk2(o.z, o.w) << 32);
    }
}

#define XB_TMO      128
#define XB_XCNT(j)  (256  + 64 * (j))
#define XB_XSUB(j)  (1280 + 64 * (j))
#define XB_XGEN(j)  (2304 + 64 * (j))
#define XB_TOP      3328
#define XB_TOPGEN   3392
#define XCD_BAR_WORDS 3456
#define XB_SPIN_CAP (1u << 18)

__device__ __forceinline__ unsigned xb_ld(unsigned* p)              { return __hip_atomic_load(p, __ATOMIC_RELAXED, __HIP_MEMORY_SCOPE_AGENT); }
__device__ __forceinline__ unsigned xb_add(unsigned* p, unsigned v) { return __hip_atomic_fetch_add(p, v, __ATOMIC_RELAXED, __HIP_MEMORY_SCOPE_AGENT); }
__device__ __forceinline__ unsigned xb_xcc_id() { return (unsigned)__builtin_amdgcn_s_getreg((3 << 11) | 20) & 0xFu; }
#define XB_SPIN(cond, bar) do { unsigned _sp = 0; while (cond) { __builtin_amdgcn_s_sleep(1); \
    if ((++_sp & 255u) == 0u) { if (xb_ld(&(bar)[XB_TMO])) break; if (_sp > XB_SPIN_CAP) { atomicAdd(&(bar)[XB_TMO], 1u); break; } } } } while (0)

struct XcdBarrier {
    unsigned* bar; unsigned x;
    volatile LAS unsigned* st;
};

__device__ __forceinline__ XcdBarrier xcd_barrier_post(unsigned* bar, volatile LAS unsigned* st) {
    XcdBarrier b; b.bar = bar; b.x = xb_xcc_id(); b.st = st;
    if (threadIdx.x == 0) (void)xb_add(&bar[XB_XCNT(b.x)], 1u);
    return b;
}
__device__ __forceinline__ void xcd_barrier_complete(unsigned* bar, unsigned x, unsigned& nloc, unsigned& nx) {
    const unsigned G = gridDim.x * gridDim.y * gridDim.z;
    unsigned sum, cnt, mine, sp = 0u;
    for (;;) {
        sum = 0u; cnt = 0u; mine = 0u;
#pragma unroll
        for (unsigned j = 0; j < 16; ++j) { const unsigned c = xb_ld(&bar[XB_XCNT(j)]); sum += c; cnt += (c > 0u) ? 1u : 0u; mine = (j == x) ? c : mine; }
        if (sum == G) break;
        __builtin_amdgcn_s_sleep(1);
        if ((++sp & 255u) == 0u) { if (xb_ld(&bar[XB_TMO])) break; if (sp > XB_SPIN_CAP) { atomicAdd(&bar[XB_TMO], 1u); break; } }
    }
    nloc = mine > 0u ? mine : 1u; nx = cnt > 0u ? cnt : 1u;
}

__device__ __forceinline__ void xcd_barrier(const XcdBarrier& b) {
    asm volatile("s_waitcnt vmcnt(0)" ::: "memory");
    __syncthreads();
    if (threadIdx.x == 0) {
        unsigned* bar = b.bar;
        __builtin_amdgcn_s_waitcnt(0);
        unsigned nloc = b.st[0], nx = b.st[1];
        if (nloc == 0u) { xcd_barrier_complete(bar, b.x, nloc, nx); b.st[0] = nloc; b.st[1] = nx; }
        const unsigned old = xb_add(&bar[XB_XSUB(b.x)], 1u);
        const unsigned gen = old / nloc;
        if (old + 1u == (gen + 1u) * nloc) {
            __builtin_amdgcn_fence(__ATOMIC_RELEASE, "agent");
            asm volatile("s_waitcnt vmcnt(0)" ::: "memory");
            const unsigned og = xb_add(&bar[XB_TOP], 1u);
            const unsigned tg = og / nx;
            if (og + 1u == (tg + 1u) * nx) xb_add(&bar[XB_TOPGEN], 1u);
            else XB_SPIN(xb_ld(&bar[XB_TOPGEN]) == tg, bar);
            __builtin_amdgcn_fence(__ATOMIC_ACQUIRE, "agent");
            xb_add(&bar[XB_XGEN(b.x)], 1u);
            asm volatile("s_waitcnt vmcnt(0)" ::: "memory");
        } else {
            XB_SPIN(xb_ld(&bar[XB_XGEN(b.x)]) == gen, bar);
            __builtin_amdgcn_fence(__ATOMIC_ACQUIRE, "agent");
            asm volatile("s_waitcnt vmcnt(0)" ::: "memory");
        }
    }
    __syncthreads();
}

constexpr int HG_G = 0, HG_TOT = 33792, HG_QP = 35840, HG_KP = 53248, HG_QPP = 70656, HG_VT = 88064, HG_PP = 106496, HG_RED = 115712;
constexpr int GST = 132;
__device__ __forceinline__ int crow(int r, int hi) { return (r & 3) + 8 * (r >> 2) + 4 * hi; }

__device__ __forceinline__ void hg_gates(LAS unsigned char* lds, const bf16* RF, size_t tile_off, const float* lbl, int h, int tid, float (&kk)[2][8]) {
    const int r0 = tid >> 4, c8 = (tid & 15) * 8;
    LAS float* G = (LAS float*)(lds + HG_G); LAS float* TOT = (LAS float*)(lds + HG_TOT);
    float lb[8];
#pragma unroll
    for (int i = 0; i < 8; ++i) { const int c = h * 128 + c8 + i; lb[i] = 1.0f / (1.0f + __expf(lbl[c] - lbl[1024 + c])); }
#pragma unroll
    for (int p = 0; p < 2; ++p) {
        const int r = r0 + 32 * p;
        const v4u w = *(const v4u*)(RF + tile_off + (size_t)r * 1024 + c8);
        float x[8] = {bflo(w.x), bfhi(w.x), bflo(w.y), bfhi(w.y), bflo(w.z), bfhi(w.z), bflo(w.w), bfhi(w.w)};
        float g[8];
#pragma unroll
        for (int i = 0; i < 8; ++i) { const float sg = 1.0f / (1.0f + __expf(-x[i])); const float f = lb[i] + (1.0f - lb[i]) * sg; g[i] = __logf(f); kk[p][i] = (1.0f - lb[i]) * (1.0f - sg); }
        *(LAS f32x4*)(G + r * GST + c8) = (f32x4){g[0], g[1], g[2], g[3]};
        *(LAS f32x4*)(G + r * GST + c8 + 4) = (f32x4){g[4], g[5], g[6], g[7]};
    }
    __syncthreads();
    {
        const int k = tid & 127, seg = tid >> 7; float v[16];
#pragma unroll
        for (int i = 0; i < 16; ++i) v[i] = G[(seg * 16 + i) * GST + k];
#pragma unroll
        for (int i = 1; i < 16; ++i) v[i] += v[i - 1];
        TOT[seg * 128 + k] = v[15];
        __syncthreads();
        float off = 0.f;
#pragma unroll
        for (int s = 0; s < 3; ++s) if (s < seg) off += TOT[s * 128 + k];
#pragma unroll
        for (int i = 0; i < 16; ++i) G[(seg * 16 + i) * GST + k] = v[i] + off;
    }
    __syncthreads();
}
__device__ __forceinline__ void ld8(const LAS float* p, float (&o)[8]) { const f32x4 a = *(const LAS f32x4*)p, b = *(const LAS f32x4*)(p + 4); o[0] = a[0]; o[1] = a[1]; o[2] = a[2]; o[3] = a[3]; o[4] = b[0]; o[5] = b[1]; o[6] = b[2]; o[7] = b[3]; }
__device__ __forceinline__ bf16x8 ldsfrag(const LAS unsigned char* p) { return *(const LAS bf16x8*)p; }

__device__ __forceinline__ void hg_unit_state(LAS unsigned char* lds, const bf16* RF, const bf16* RI, const float* lbl, bf16* Ust, float* dec, int unit, int tid) {
    const int bl = unit >> 10, h = (unit >> 7) & 7, c = unit & 127;
    const size_t tile_off = ((size_t)bl * SEQ + (size_t)c * 64) * 1024 + h * 128;
    const int r0 = tid >> 4, c8 = (tid & 15) * 8, lane = tid & 63, wid = tid >> 6, r32 = lane & 31, hi = lane >> 5;
    v4u vv[2];
#pragma unroll
    for (int p = 0; p < 2; ++p) vv[p] = *(const v4u*)(RI + tile_off + (size_t)(r0 + 32 * p) * 1024 + c8);
    float kk[2][8];
    hg_gates(lds, RF, tile_off, lbl, h, tid, kk);
    const LAS float* G = (const LAS float*)(lds + HG_G);
    LAS bf16* KT = (LAS bf16*)(lds + HG_KP); LAS bf16* VT = (LAS bf16*)(lds + HG_VT);
    float bl8[8]; ld8(G + 63 * GST + c8, bl8);
#pragma unroll
    for (int p = 0; p < 2; ++p) {
        const int r = r0 + 32 * p; float b8[8]; ld8(G + r * GST + c8, b8);
        const unsigned vw[4] = {vv[p].x, vv[p].y, vv[p].z, vv[p].w};
#pragma unroll
        for (int i = 0; i < 8; ++i) {
            KT[(c8 + i) * 72 + r] = (bf16)f2bf(kk[p][i] * __expf(bl8[i] - b8[i]));
            VT[(c8 + i) * 72 + r] = (bf16)((i & 1) ? (vw[i >> 1] >> 16) : (vw[i >> 1] & 0xffffu));
        }
    }
    if (tid < 128) dec[(size_t)unit * 128 + tid] = __expf(G[63 * GST + tid]);
    __syncthreads();
    const int jb = wid >> 1, kb0 = (wid & 1) * 2;
    f32x16 a0 = {}, a1 = {};
#pragma unroll
    for (int ks = 0; ks < 4; ++ks) {
        const bf16x8 av = ldsfrag(lds + HG_VT + ((jb * 32 + r32) * 72 + ks * 16 + hi * 8) * 2);
        const bf16x8 b0 = ldsfrag(lds + HG_KP + ((kb0 * 32 + r32) * 72 + ks * 16 + hi * 8) * 2);
        const bf16x8 b1 = ldsfrag(lds + HG_KP + (((kb0 + 1) * 32 + r32) * 72 + ks * 16 + hi * 8) * 2);
        a0 = __builtin_amdgcn_mfma_f32_32x32x16_bf16(av, b0, a0, 0, 0, 0);
        a1 = __builtin_amdgcn_mfma_f32_32x32x16_bf16(av, b1, a1, 0, 0, 0);
    }
    bf16* up = Ust + (size_t)unit * 16384;
#pragma unroll
    for (int r = 0; r < 16; ++r) { const int j = jb * 32 + crow(r, hi);
        up[j * 128 + kb0 * 32 + r32] = (bf16)f2bf(a0[r]); up[j * 128 + (kb0 + 1) * 32 + r32] = (bf16)f2bf(a1[r]); }
    __syncthreads();
}

__device__ __forceinline__ void hg_unit_out(LAS unsigned char* lds, bf16* RQ, const bf16* RF, const bf16* RI, const bf16* RG, const float* lbl, const float* rnw,
                                            const bf16* Sin, int unit, int tid) {
    const int bl = unit >> 10, h = (unit >> 7) & 7, c = unit & 127;
    const size_t tile_off = ((size_t)bl * SEQ + (size_t)c * 64) * 1024 + h * 128;
    const int r0 = tid >> 4, c8 = (tid & 15) * 8, lane = tid & 63, wid = tid >> 6, r32 = lane & 31, hi = lane >> 5;
    v4u vv[2], qq[2];
#pragma unroll
    for (int p = 0; p < 2; ++p) { vv[p] = *(const v4u*)(RI + tile_off + (size_t)(r0 + 32 * p) * 1024 + c8); qq[p] = *(const v4u*)(RQ + tile_off + (size_t)(r0 + 32 * p) * 1024 + c8); }
    const int tb = wid & 1, jb = wid >> 1;
    v4u sf[8];
    { const bf16* sp = Sin + (size_t)unit * 16384 + (size_t)(jb * 32 + r32) * 128 + hi * 8;
#pragma unroll
      for (int ks = 0; ks < 8; ++ks) sf[ks] = *(const v4u*)(sp + ks * 16); }
    float kk[2][8];
    hg_gates(lds, RF, tile_off, lbl, h, tid, kk);
    const LAS float* G = (const LAS float*)(lds + HG_G);
    LAS bf16* VT = (LAS bf16*)(lds + HG_VT);
    float bm8[8]; ld8(G + 31 * GST + c8, bm8);
#pragma unroll
    for (int p = 0; p < 2; ++p) {
        const int r = r0 + 32 * p; float b8[8]; ld8(G + r * GST + c8, b8);
        const unsigned vw[4] = {vv[p].x, vv[p].y, vv[p].z, vv[p].w};
        const float q8[8] = {bflo(qq[p].x), bfhi(qq[p].x), bflo(qq[p].y), bfhi(qq[p].y), bflo(qq[p].z), bfhi(qq[p].z), bflo(qq[p].w), bfhi(qq[p].w)};
        float qp[8], kp[8], qpp[8];
#pragma unroll
        for (int i = 0; i < 8; ++i) { const float e = __expf(b8[i] - bm8[i]); qp[i] = q8[i] * e; kp[i] = kk[p][i] * __expf(bm8[i] - b8[i]); qpp[i] = q8[i] * __expf(b8[i]);
            VT[(c8 + i) * 72 + r] = (bf16)((i & 1) ? (vw[i >> 1] >> 16) : (vw[i >> 1] & 0xffffu)); }
        *(LAS v4u*)(lds + HG_QP + (r * 136 + c8) * 2) = (v4u){pk2(qp[0], qp[1]), pk2(qp[2], qp[3]), pk2(qp[4], qp[5]), pk2(qp[6], qp[7])};
        *(LAS v4u*)(lds + HG_KP + (r * 136 + c8) * 2) = (v4u){pk2(kp[0], kp[1]), pk2(kp[2], kp[3]), pk2(kp[4], kp[5]), pk2(kp[6], kp[7])};
        *(LAS v4u*)(lds + HG_QPP + (r * 136 + c8) * 2) = (v4u){pk2(qpp[0], qpp[1]), pk2(qpp[2], qpp[3]), pk2(qpp[4], qpp[5]), pk2(qpp[6], qpp[7])};
    }
    __syncthreads();
    if (wid < 4) {
        const int stb = wid & 1, ssb = wid >> 1;
        f32x16 sc = {};
        if (ssb <= stb) {
#pragma unroll
            for (int ks = 0; ks < 8; ++ks) {
                const bf16x8 av = ldsfrag(lds + HG_QP + ((stb * 32 + r32) * 136 + ks * 16 + hi * 8) * 2);
                const bf16x8 bv = ldsfrag(lds + HG_KP + ((ssb * 32 + r32) * 136 + ks * 16 + hi * 8) * 2);
                sc = __builtin_amdgcn_mfma_f32_32x32x16_bf16(av, bv, sc, 0, 0, 0);
            }
        }
        LAS bf16* PP = (LAS bf16*)(lds + HG_PP);
        const int s = ssb * 32 + r32;
#pragma unroll
        for (int r = 0; r < 16; ++r) { const int t = stb * 32 + crow(r, hi); const float v = (ssb <= stb && s <= t) ? sc[r] : 0.f; PP[t * 72 + s] = (bf16)f2bf(v); }
    }
    __syncthreads();
    f32x16 o = {};
#pragma unroll
    for (int ks = 0; ks < 4; ++ks) {
        const bf16x8 av = ldsfrag(lds + HG_PP + ((tb * 32 + r32) * 72 + ks * 16 + hi * 8) * 2);
        const bf16x8 bv = ldsfrag(lds + HG_VT + ((jb * 32 + r32) * 72 + ks * 16 + hi * 8) * 2);
        o = __builtin_amdgcn_mfma_f32_32x32x16_bf16(av, bv, o, 0, 0, 0);
    }
#pragma unroll
    for (int ks = 0; ks < 8; ++ks) {
        const bf16x8 av = ldsfrag(lds + HG_QPP + ((tb * 32 + r32) * 136 + ks * 16 + hi * 8) * 2);
        o = __builtin_amdgcn_mfma_f32_32x32x16_bf16(av, __builtin_bit_cast(bf16x8, sf[ks]), o, 0, 0, 0);
    }
    LAS float* RED = (LAS float*)(lds + HG_RED);
    float ssq[16];
#pragma unroll
    for (int r = 0; r < 16; ++r) { float s = o[r] * o[r]; s += __shfl_xor(s, 1); s += __shfl_xor(s, 2); s += __shfl_xor(s, 4); s += __shfl_xor(s, 8); s += __shfl_xor(s, 16); ssq[r] = s; }
    if (r32 == 0) {
#pragma unroll
        for (int r = 0; r < 16; ++r) RED[jb * 64 + tb * 32 + crow(r, hi)] = ssq[r];
    }
    __syncthreads();
    const int j = jb * 32 + r32; const float wj = rnw[j];
#pragma unroll
    for (int r = 0; r < 16; ++r) {
        const int t = tb * 32 + crow(r, hi);
        const float tot = RED[t] + RED[64 + t] + RED[128 + t] + RED[192 + t];
        const float rstd = 1.0f / sqrtf(tot * (1.f / 128.f) + EPS);
        const size_t go = tile_off + (size_t)t * 1024 + j;
        const float g = __uint_as_float((unsigned)RG[go] << 16);
        const float sl = g / (1.0f + __expf(-g));
        RQ[go] = (bf16)f2bf(o[r] * rstd * wj * sl);
    }
    __syncthreads();
}

__global__ void __launch_bounds__(NTHR, 2) fused_fwd(Args args) {
    extern __shared__ __attribute__((aligned(16))) unsigned char lds_raw[];
    cg::grid_group grid = cg::this_grid();
    LAS unsigned char* lds = (LAS unsigned char*)lds_raw;
    const int tid = threadIdx.x, lane = tid & 63, wave = __builtin_amdgcn_readfirstlane(tid >> 6);
    const int G = gridDim.x, bx = blockIdx.x;
    const int vcu = (G % 8 == 0) ? (bx % 8) * (G / 8) + bx / 8 : bx;
    const int gw = vcu * NWAVES + wave, NGW = G * NWAVES;
    unsigned char* ws = args.ws;
    const float* x = args.in[0]; const float* cvec = args.in[1];
    const float* w_ada = args.in[3]; const float* b_ada = args.in[4]; const float* norm_mix = args.in[5]; const float* w_in = args.in[6];
    const float* lam_q1 = args.in[7]; const float* lam_k1 = args.in[8]; const float* lam_q2 = args.in[9]; const float* lam_k2 = args.in[10];
    const float* subln_w = args.in[11]; const float* lb_logits = args.in[12]; const float* rec_norm_w = args.in[13];
    const float* w_pa = args.in[14]; const float* w_pr = args.in[15]; const float* w_out = args.in[16]; const float* norm_mlp = args.in[17];
    const float* w1 = args.in[18]; const float* w2 = args.in[19]; const float* norm_final = args.in[20];
    float* ada = (float*)(ws + WS_ADA); float* rope = (float*)(ws + WS_ROPE);
    bf16* Win_t = (bf16*)(ws + WS_WIN); bf16* Wpa_t = (bf16*)(ws + WS_WPA); bf16* Wpr_t = (bf16*)(ws + WS_WPR); bf16* Wout_t = (bf16*)(ws + WS_WOUT);
    bf16* W1_t = (bf16*)(ws + WS_W1); bf16* W2_t = (bf16*)(ws + WS_W2);
    bf16* XN = (bf16*)(ws + WS_XN); bf16* Y = (bf16*)(ws + WS_Y); bf16* P = (bf16*)(ws + WS_P); float* dec = (float*)(ws + WS_DEC);
    bf16* Pq = P, *Pk = P + PBUF, *Pv = P + 2 * PBUF, *Prq = P + 3 * PBUF, *Prf = P + 4 * PBUF, *Pri = P + 5 * PBUF, *Prg = P + 6 * PBUF, *Pga = P + 7 * PBUF, *Pgr = P + 8 * PBUF;
    float* Y1 = (float*)P;
    bf16* Oa = Pv;
    bf16* UH = P;
    unsigned char* dob = (unsigned char*)args.out;
    bf16* O0 = (bf16*)(dob + DO_O0); bf16* O1 = (bf16*)(dob + DO_O1); bf16* Ust = (bf16*)(dob + DO_UST);

    unsigned* barw = (unsigned*)(ws + WS_BAR);
    if (bx == 0) for (int i = tid; i < XCD_BAR_WORDS; i += NTHR) barw[i] = 0u;
    volatile LAS unsigned* bst = (volatile LAS unsigned*)(lds + 131072 + 512);
    if (tid < 2) bst[tid] = 0u;
    __syncthreads();
    if (bx < 96) {
        LAS float* scs = (LAS float*)lds;
        LAS float* part = (LAS float*)(lds + 16384);
        for (int i = tid; i < 4096; i += NTHR) { const float v = cvec[i]; scs[i] = v / (1.0f + __expf(-v)); }
        __syncthreads();
        const int n = bx * 64 + lane; float a0 = 0.f, a1 = 0.f, a2 = 0.f, a3 = 0.f;
        const float* wp = w_ada + (size_t)(wave * 128) * 6144 + n;
#pragma unroll 8
        for (int k = 0; k < 128; ++k) { const float wv = wp[(size_t)k * 6144]; const int kk = wave * 128 + k;
            a0 += scs[kk] * wv; a1 += scs[1024 + kk] * wv; a2 += scs[2048 + kk] * wv; a3 += scs[3072 + kk] * wv; }
        part[(wave * 4 + 0) * 64 + lane] = a0; part[(wave * 4 + 1) * 64 + lane] = a1; part[(wave * 4 + 2) * 64 + lane] = a2; part[(wave * 4 + 3) * 64 + lane] = a3;
        __syncthreads();
        if (wave < 4) { float s = b_ada[n];
#pragma unroll
            for (int w = 0; w < 8; ++w) s += part[(w * 4 + wave) * 64 + lane];
            ada[wave * 6144 + n] = s; }
        __syncthreads();
    }
    {
        LAS float* scr = (LAS float*)(lds + wave * 16384);
        constexpr int I_IN = 16 * (NIN / 32), I_SQ = 16 * 32, I_1 = 16 * (FF / 32), I_2 = (FF / 64) * 32;
        constexpr int NITEMS = I_IN + 3 * I_SQ + I_1 + I_2;
        for (int it = gw; it < NITEMS; it += NGW) {
            int r = it;
            if (r < I_IN) { p0_transpose_item(w_in, DM, NIN, Win_t, scr, r, lane); continue; } r -= I_IN;
            if (r < I_SQ) { p0_transpose_item(w_pa, DM, DM, Wpa_t, scr, r, lane); continue; } r -= I_SQ;
            if (r < I_SQ) { p0_transpose_item(w_pr, DM, DM, Wpr_t, scr, r, lane); continue; } r -= I_SQ;
            if (r < I_SQ) { p0_transpose_item(w_out, DM, DM, Wout_t, scr, r, lane); continue; } r -= I_SQ;
            if (r < I_1) { p0_transpose_item(w1, DM, FF, W1_t, scr, r, lane); continue; } r -= I_1;
            p0_transpose_item(w2, FF, DM, W2_t, scr, r, lane);
        }
        const float invf[8] = {1.0f, 0.1939227432012558f, 0.03760603070259094f, 0.007292664609849453f, 0.0014142135623842478f, 0.00027424818836152554f, 5.318296098266728e-05f, 1.0313386155758053e-05f};
        for (int row = bx * NTHR + tid; row < TT; row += G * NTHR) { const float pf = (float)args.pos[row];
#pragma unroll
            for (int i = 0; i < 8; ++i) { const float ang = pf * invf[i]; float sv, cv; sincosf(ang, &sv, &cv); rope[row * 16 + i] = cv; rope[row * 16 + 8 + i] = sv; } }
    }
    grid.sync();
    XcdBarrier xbar = xcd_barrier_post(barw, bst);
    for (int m = gw; m < TT; m += NGW) { const int b = m >> 13;
        norm_mod_row(x + (size_t)m * DM, norm_mix, ada + b * 6144 + 1024, ada + b * 6144, XN + (size_t)m * DM, lane); }
    xcd_barrier(xbar);

    for (int half = 0; half < 2; ++half) {
        { pg8::Gemm g{XN + (size_t)half * TH * DM, Win_t, TH, NIN, DM}; pg8::StaticOrder S; S.init(TH, NIN, G, bx);
          pg8::EpiInProj E{P, rope + (size_t)half * TH * 16};
          pg8::gemm_phase<pg8::EpiInProj, pg8::StaticOrder, true, true>(lds, g, S, E); }
        xcd_barrier(xbar);
        for (int cb = vcu; cb < 512; cb += G) {
            const int s = cb & 7, vb = cb >> 3;
            for (int i = 0; i < 4; ++i) {
                const int qb = (i == 0) ? s : (i == 1) ? 15 - s : (i == 2) ? 16 + s : 31 - s;
                const int b = vb >> 5, h = (vb >> 2) & 7, m = (vb >> 1) & 1, e = vb & 1;
                attn_body::attn_unit<8>(b, h * 2 + m, h * 2 + e, qb, (const attn_body::bf16*)Pq, (const attn_body::bf16*)Pk, (const attn_body::bf16*)Pv,
                                        (attn_body::bf16*)(m ? O1 : O0), (char*)lds_raw);
            }
        }
        { const int t3 = fresh_tid(); for (int u = vcu; u < 2048; u += G) hg_unit_state(lds, Prf, Pri, lb_logits, Ust, dec, u, t3); }
        xcd_barrier(xbar);
        for (int gid = vcu * NTHR + fresh_tid(); gid < 131072; gid += G * NTHR) {
            const int bh = gid >> 13, e2 = gid & 8191, k0 = (2 * e2) & 127;
            unsigned* up = (unsigned*)(Ust + (size_t)bh * 128 * 16384 + 2 * e2);
            const float* dp = dec + (size_t)bh * 128 * 128 + k0;
            float s0 = 0.f, s1 = 0.f;
            for (int c0 = 0; c0 < 128; c0 += 16) {
                unsigned uu[16]; float d0[16], d1[16];
#pragma unroll
                for (int i = 0; i < 16; ++i) { uu[i] = up[(size_t)(c0 + i) * 8192]; const float2 dd = *(const float2*)(dp + (c0 + i) * 128); d0[i] = dd.x; d1[i] = dd.y; }
#pragma unroll
                for (int i = 0; i < 16; ++i) { up[(size_t)(c0 + i) * 8192] = pk2(s0, s1); s0 = d0[i] * s0 + bflo(uu[i]); s1 = d1[i] * s1 + bfhi(uu[i]); }
            }
        }
        xcd_barrier(xbar);
        { const int t5 = fresh_tid(); for (int u = vcu; u < 2048; u += G) hg_unit_out(lds, Prq, Prf, Pri, Prg, lb_logits, rec_norm_w, Ust, u, t5); }
        { const int lane = fresh_tid() & 63;
          float lam; { const float d1 = wave_sum(lam_q1[lane] * lam_k1[lane]), d2 = wave_sum(lam_q2[lane] * lam_k2[lane]); lam = __expf(d1) - __expf(d2) + 0.2f; }
        for (int m = gw; m < TH; m += NGW) {
            const v4u* a = (const v4u*)(O0 + (size_t)m * DM) + lane * 2; const v4u* b = (const v4u*)(O1 + (size_t)m * DM) + lane * 2;
            const v4u a0 = a[0], a1 = a[1], b0 = b[0], b1 = b[1];
            const unsigned aw[8] = {a0.x, a0.y, a0.z, a0.w, a1.x, a1.y, a1.z, a1.w}, bw[8] = {b0.x, b0.y, b0.z, b0.w, b1.x, b1.y, b1.z, b1.w};
            float o[16]; float ss = 0.f;
#pragma unroll
            for (int i = 0; i < 8; ++i) { o[2 * i] = bflo(aw[i]) - lam * bflo(bw[i]); o[2 * i + 1] = bfhi(aw[i]) - lam * bfhi(bw[i]); ss += o[2 * i] * o[2 * i] + o[2 * i + 1] * o[2 * i + 1]; }
            ss += __shfl_xor(ss, 1); ss += __shfl_xor(ss, 2); ss += __shfl_xor(ss, 4);
            const float rstd = 0.8f / sqrtf(ss * (1.f / 128.f) + EPS);
            const float* wp = subln_w + (lane & 7) * 16;
            unsigned ow[8];
#pragma unroll
            for (int i = 0; i < 8; ++i) ow[i] = pk2(o[2 * i] * rstd * wp[2 * i], o[2 * i + 1] * rstd * wp[2 * i + 1]);
            v4u* op = (v4u*)(Oa + (size_t)m * DM) + lane * 2;
            op[0] = (v4u){ow[0], ow[1], ow[2], ow[3]}; op[1] = (v4u){ow[4], ow[5], ow[6], ow[7]};
        } }
        xcd_barrier(xbar);
        { pg8::Gemm g{Oa, Wpa_t, TH, DM, DM}; pg8::StaticOrder S; S.init(TH, DM, G, bx);
          pg8::EpiGate1 E{Pga, Y1};
          pg8::gemm_phase<pg8::EpiGate1, pg8::StaticOrder, true, true>(lds, g, S, E); }
        xcd_barrier(xbar);
        { pg8::Gemm g{Prq, Wpr_t, TH, DM, DM}; pg8::StaticOrder S; S.init(TH, DM, G, bx);
          pg8::EpiGate2 E{Pgr, Y1, Y + (size_t)half * TH * DM};
          pg8::gemm_phase<pg8::EpiGate2, pg8::StaticOrder, true, true>(lds, g, S, E); }
        xcd_barrier(xbar);
    }
    { pg8::Gemm g{Y, Wout_t, TT, DM, DM}; pg8::StaticOrder S; S.init(TT, DM, G, bx);
      pg8::EpiRes E{x, args.out, ada + 2048};
      pg8::gemm_phase<pg8::EpiRes, pg8::StaticOrder, true, true>(lds, g, S, E); }
    xcd_barrier(xbar);
    for (int m = gw; m < TT; m += NGW) { const int b = m >> 13;
        norm_mod_row(args.out + (size_t)m * DM, norm_mlp, ada + b * 6144 + 4096, ada + b * 6144 + 3072, XN + (size_t)m * DM, lane); }
    xcd_barrier(xbar);
    { pg8::Gemm g{XN, W1_t, TT, FF, DM}; pg8::StaticOrder S; S.init(TT, FF, G, bx);
      pg8::EpiRelu2 E{UH, FF};
      pg8::gemm_phase<pg8::EpiRelu2, pg8::StaticOrder, true, true>(lds, g, S, E); }
    xcd_barrier(xbar);
    { pg8::Gemm g{UH, W2_t, TT, DM, FF}; pg8::StaticOrder S; S.init(TT, DM, G, bx);
      pg8::EpiRes E{args.out, args.out, ada + 5120};
      pg8::gemm_phase<pg8::EpiRes, pg8::StaticOrder, true, true>(lds, g, S, E); }
    xcd_barrier(xbar);
    for (int m = gw; m < TT; m += NGW) {
        f32x4* xr = (f32x4*)(args.out + (size_t)m * DM) + lane;
        f32x4 v[4]; float s = 0.f;
#pragma unroll
        for (int j = 0; j < 4; ++j) { v[j] = xr[64 * j]; s += (v[j].x * v[j].x + v[j].y * v[j].y) + (v[j].z * v[j].z + v[j].w * v[j].w); }
        const float rinv = 1.0f / sqrtf(wave_sum(s) * (1.f / 1024.f) + EPS);
#pragma unroll
        for (int j = 0; j < 4; ++j) xr[64 * j] = v[j] * rinv * ((const f32x4*)norm_final)[lane + 64 * j];
    }
}

extern "C" void kernel_launch(void* const* d_in, const int* in_sizes, int n_in, void* d_out, int out_size, void* d_ws, size_t ws_size, hipStream_t stream) {
    static int grid = 0;
    if (grid == 0) {
        if (n_in != 21 || in_sizes[0] != TT * DM || out_size != TT * DM || ws_size < WS_END) {
            fprintf(stderr, "kernel_launch: unexpected shapes: n_in %d in0 %d out %d ws %zu (need %zu)\n", n_in, n_in > 0 ? in_sizes[0] : -1, out_size, ws_size, (size_t)WS_END); grid = -1; return; }
        int dev = 0, cus = 0, per_cu = 0;
        hipGetDevice(&dev); hipDeviceGetAttribute(&cus, hipDeviceAttributeMultiprocessorCount, dev);
        if (hipFuncSetAttribute((const void*)fused_fwd, hipFuncAttributeMaxDynamicSharedMemorySize, LDS_BYTES) != hipSuccess) { fprintf(stderr, "kernel_launch: hipFuncSetAttribute failed\n"); grid = -1; return; }
        if (hipOccupancyMaxActiveBlocksPerMultiprocessor(&per_cu, (const void*)fused_fwd, NTHR, LDS_BYTES) != hipSuccess || per_cu < 1) { fprintf(stderr, "kernel_launch: occupancy query says %d\n", per_cu); per_cu = 1; }
        (void)hipGetLastError();
        grid = cus * 1;
        (void)per_cu;
    }
    if (grid < 0) return;
    Args a{};
    for (int i = 0; i < 21; ++i) a.in[i] = (const float*)d_in[i];
    a.pos = (const int*)d_in[2]; a.out = (float*)d_out; a.ws = (unsigned char*)d_ws;
    void* kargs[] = {&a};
    hipError_t e = hipLaunchCooperativeKernel((const void*)fused_fwd, dim3(grid), dim3(NTHR), kargs, LDS_BYTES, stream);
    if (e != hipSuccess) fprintf(stderr, "cooperative launch failed: %s (grid %d)\n", hipGetErrorString(e), grid);
}
```

```cpp
#include <hip/hip_runtime.h>
#include <hip/hip_cooperative_groups.h>
#include <cstdio>
#include <cstdint>
namespace cg = cooperative_groups;
__device__ __forceinline__ int fresh_tid() { int t = threadIdx.x; asm volatile("" : "+v"(t)); return t; }
namespace pg8 {
#define PG8_LAS __attribute__((address_space(3)))
typedef unsigned short bf16_t;
typedef short bf16x8 __attribute__((ext_vector_type(8)));
typedef float f32x4 __attribute__((ext_vector_type(4)));
typedef unsigned u32x4 __attribute__((ext_vector_type(4)));
constexpr int BM = 256, BK = 64, HALF = 128, HTB = HALF * BK * 2  , STAGE_BYTES = 8 * HTB, NXCD = 8, WGM = 8;

__host__ __device__ __forceinline__ int lds_byte(int r, int c) { const int st = (r >> 4) * 2 + (c >> 5), rr = r & 15, cc = c & 31, ob = rr * 64 + cc * 2; return st * 1024 + (ob ^ (((ob >> 9) & 1) << 5)); }
__host__ __device__ __forceinline__ void stage_rc(int b, int& R, int& C) { const int st = b / 1024, sb = b % 1024, swz = sb ^ (((sb >> 9) & 1) << 5); R = (st >> 1) * 16 + swz / 64; C = (st & 1) * 32 + (swz % 64) / 2; }
__host__ __device__ __forceinline__ int perm32(int rho) { const int n = rho >> 4, i = rho & 15; return 8 * (i >> 2) + 4 * n + (i & 3); }

struct Unit { int pm, pn; };
struct Gemm { const bf16_t* A; const bf16_t* Bt; int M, N, K; };

struct StaticOrder {
    int nM, nN, nwg, G, c;
    __host__ __device__ void init(int M, int N, int G_, int c_) { nM = M / BM; nN = N / BM; nwg = nM * nN; G = G_; c = c_; }
    __host__ __device__ bool next(int i, Unit& u) const {
        const long L = (long)i * G + c; if (L >= nwg) return false;
        int wgid = (int)L; { const int q = nwg / NXCD, r = nwg % NXCD, xcd = wgid % NXCD, off = wgid / NXCD; wgid = (xcd < r ? xcd * (q + 1) : r * (q + 1) + (xcd - r) * q) + off; }
        const int nig = WGM * nN, gid = wgid / nig, fm = gid * WGM, gsz = (nM - fm) < WGM ? (nM - fm) : WGM;
        u.pm = fm + ((wgid % nig) % gsz); u.pn = (wgid % nig) / gsz; return true;
    }
    __device__ __forceinline__ void a_ready(const Unit&) const {}
    __device__ __forceinline__ void done(const Unit&) const {}
};

__device__ __forceinline__ unsigned cvt_pk_bf16(float lo, float hi) { unsigned r; asm volatile("v_cvt_pk_bf16_f32 %0, %1, %2" : "=v"(r) : "v"(lo), "v"(hi)); return r; }
__device__ __forceinline__ float bf_lo(unsigned w) { return __uint_as_float(w << 16); }
__device__ __forceinline__ float bf_hi(unsigned w) { return __uint_as_float(w & 0xffff0000u); }
__device__ __forceinline__ float sigmoidf_(float x) { return __builtin_amdgcn_rcpf(1.0f + __expf(-x)); }
constexpr int TH_ROWS = 16384;
constexpr float QSCALE = 0.125f * 1.4426950408889634f;

struct EpiInProj {
    static constexpr bool PERM = true, AFTER_DRAIN = false;
    bf16_t* P; const float* rope;
    __device__ __forceinline__ void operator()(const f32x4 (&acc)[2][2][4][2], const Unit& u, int wr, int wc, int fr, int fq) const {
        const int t = u.pn >> 2, colt = (u.pn & 3) * 256;
        bf16_t* base = P + (size_t)t * TH_ROWS * 1024;
        const int row0 = u.pm * BM + wr * 64 + fr, col0 = colt + wc * 32 + 8 * fq;
        const bool isrope = (t < 2) && ((wc & 1) == 0);
        const float sc = (t == 0) ? QSCALE : 1.f;
        const float sgn = (fq == 0) ? -1.f : ((fq == 1) ? 1.f : 0.f);
#pragma unroll
        for (int ai = 0; ai < 2; ++ai)
#pragma unroll
            for (int m = 0; m < 4; ++m) {
                const int row = row0 + ai * HALF + m * 16;
                f32x4 c0 = {1.f, 1.f, 1.f, 1.f}, c1 = c0, s0 = {0.f, 0.f, 0.f, 0.f}, s1 = s0;
                if (isrope) { const f32x4* rp = (const f32x4*)(rope + (size_t)row * 16); f32x4 a = rp[0], b = rp[1], c = rp[2], d = rp[3];
                    if (fq < 2) { c0 = a; c1 = b; } s0 = c * sgn; s1 = d * sgn; }
                bf16_t* rowp = base + (size_t)row * 1024 + col0;
#pragma unroll
                for (int bj = 0; bj < 2; ++bj) {
                    f32x4 v0 = acc[ai][bj][m][0], v1 = acc[ai][bj][m][1];
                    if (isrope) {
                        f32x4 p0, p1;
#pragma unroll
                        for (int j = 0; j < 4; ++j) { p0[j] = __shfl_xor(v0[j], 16); p1[j] = __shfl_xor(v1[j], 16); }
                        v0 = v0 * c0 + p0 * s0; v1 = v1 * c1 + p1 * s1;
                    }
                    v0 = v0 * sc; v1 = v1 * sc;
                    u32x4 w; w.x = cvt_pk_bf16(v0[0], v0[1]); w.y = cvt_pk_bf16(v0[2], v0[3]); w.z = cvt_pk_bf16(v1[0], v1[1]); w.w = cvt_pk_bf16(v1[2], v1[3]);
                    *(u32x4*)(rowp + bj * HALF) = w;
                }
            }
    }
};
struct EpiGate1 {
    static constexpr bool PERM = true, AFTER_DRAIN = false;
    const bf16_t* gate; float* Y1;
    __device__ __forceinline__ void operator()(const f32x4 (&acc)[2][2][4][2], const Unit& u, int wr, int wc, int fr, int fq) const {
        const int row0 = u.pm * BM + wr * 64 + fr, col0 = u.pn * BM + wc * 32 + 8 * fq;
#pragma unroll
        for (int ai = 0; ai < 2; ++ai)
#pragma unroll
            for (int m = 0; m < 4; ++m) {
                const size_t off = (size_t)(row0 + ai * HALF + m * 16) * 1024 + col0;
#pragma unroll
                for (int bj = 0; bj < 2; ++bj) {
                    const u32x4 g = *(const u32x4*)(gate + off + bj * HALF);
                    f32x4 v0 = acc[ai][bj][m][0], v1 = acc[ai][bj][m][1];
                    v0[0] *= sigmoidf_(bf_lo(g.x)); v0[1] *= sigmoidf_(bf_hi(g.x)); v0[2] *= sigmoidf_(bf_lo(g.y)); v0[3] *= sigmoidf_(bf_hi(g.y));
                    v1[0] *= sigmoidf_(bf_lo(g.z)); v1[1] *= sigmoidf_(bf_hi(g.z)); v1[2] *= sigmoidf_(bf_lo(g.w)); v1[3] *= sigmoidf_(bf_hi(g.w));
                    *(f32x4*)(Y1 + off + bj * HALF) = v0; *(f32x4*)(Y1 + off + bj * HALF + 4) = v1;
                }
            }
    }
};
struct EpiGate2 {
    static constexpr bool PERM = true, AFTER_DRAIN = false;
    const bf16_t* gate; const float* Y1; bf16_t* Y;
    __device__ __forceinline__ void operator()(const f32x4 (&acc)[2][2][4][2], const Unit& u, int wr, int wc, int fr, int fq) const {
        const int row0 = u.pm * BM + wr * 64 + fr, col0 = u.pn * BM + wc * 32 + 8 * fq;
#pragma unroll
        for (int ai = 0; ai < 2; ++ai)
#pragma unroll
            for (int m = 0; m < 4; ++m) {
                const size_t off = (size_t)(row0 + ai * HALF + m * 16) * 1024 + col0;
#pragma unroll
                for (int bj = 0; bj < 2; ++bj) {
                    const u32x4 g = *(const u32x4*)(gate + off + bj * HALF);
                    const f32x4 y0 = *(const f32x4*)(Y1 + off + bj * HALF), y1 = *(const f32x4*)(Y1 + off + bj * HALF + 4);
                    f32x4 v0 = acc[ai][bj][m][0], v1 = acc[ai][bj][m][1];
                    v0[0] = y0[0] + v0[0] * sigmoidf_(bf_lo(g.x)); v0[1] = y0[1] + v0[1] * sigmoidf_(bf_hi(g.x)); v0[2] = y0[2] + v0[2] * sigmoidf_(bf_lo(g.y)); v0[3] = y0[3] + v0[3] * sigmoidf_(bf_hi(g.y));
                    v1[0] = y1[0] + v1[0] * sigmoidf_(bf_lo(g.z)); v1[1] = y1[1] + v1[1] * sigmoidf_(bf_hi(g.z)); v1[2] = y1[2] + v1[2] * sigmoidf_(bf_lo(g.w)); v1[3] = y1[3] + v1[3] * sigmoidf_(bf_hi(g.w));
                    u32x4 w; w.x = cvt_pk_bf16(v0[0], v0[1]); w.y = cvt_pk_bf16(v0[2], v0[3]); w.z = cvt_pk_bf16(v1[0], v1[1]); w.w = cvt_pk_bf16(v1[2], v1[3]);
                    *(u32x4*)(Y + off + bj * HALF) = w;
                }
            }
    }
};
struct EpiRes {
    static constexpr bool PERM = false, AFTER_DRAIN = false;
    const float* base; float* out; const float* gate;
    __device__ __forceinline__ void operator()(const f32x4 (&acc)[2][2][4][2], const Unit& u, int wr, int wc, int fr, int fq) const {
        const int row0 = u.pm * BM + wr * 64 + fr, col0 = u.pn * BM + wc * 32 + 4 * fq;
        const float* gp = gate + (size_t)((u.pm * BM) >> 13) * 6144 + col0;
        f32x4 gv[2][2];
#pragma unroll
        for (int bj = 0; bj < 2; ++bj)
#pragma unroll
            for (int n = 0; n < 2; ++n) gv[bj][n] = *(const f32x4*)(gp + bj * HALF + n * 16);
#pragma unroll
        for (int ai = 0; ai < 2; ++ai)
#pragma unroll
            for (int m = 0; m < 4; ++m) {
                const size_t off = (size_t)(row0 + ai * HALF + m * 16) * 1024 + col0;
#pragma unroll
                for (int bj = 0; bj < 2; ++bj)
#pragma unroll
                    for (int n = 0; n < 2; ++n) { const f32x4 bs = *(const f32x4*)(base + off + bj * HALF + n * 16);
                        *(f32x4*)(out + off + bj * HALF + n * 16) = bs + gv[bj][n] * acc[ai][bj][m][n]; }
            }
    }
};
struct EpiRelu2 {
    static constexpr bool PERM = true, AFTER_DRAIN = false;
    bf16_t* O; int ldc;
    __device__ __forceinline__ void operator()(const f32x4 (&acc)[2][2][4][2], const Unit& u, int wr, int wc, int fr, int fq) const {
        const int row0 = u.pm * BM + wr * 64 + fr, col0 = u.pn * BM + wc * 32 + 8 * fq;
#pragma unroll
        for (int ai = 0; ai < 2; ++ai)
#pragma unroll
            for (int m = 0; m < 4; ++m) {
                bf16_t* rowp = O + (size_t)(row0 + ai * HALF + m * 16) * ldc + col0;
#pragma unroll
                for (int bj = 0; bj < 2; ++bj) {
                    f32x4 v0 = acc[ai][bj][m][0], v1 = acc[ai][bj][m][1];
#pragma unroll
                    for (int j = 0; j < 4; ++j) { const float a = fmaxf(v0[j], 0.f), b = fmaxf(v1[j], 0.f); v0[j] = a * a; v1[j] = b * b; }
                    u32x4 w; w.x = cvt_pk_bf16(v0[0], v0[1]); w.y = cvt_pk_bf16(v0[2], v0[3]); w.z = cvt_pk_bf16(v1[0], v1[1]); w.w = cvt_pk_bf16(v1[2], v1[3]);
                    *(u32x4*)(rowp + bj * HALF) = w;
                }
            }
    }
};
template <class Epi, class Sched, bool ALIGN_EPI = false, bool SP2 = false>
__device__ __forceinline__ void gemm_phase(PG8_LAS unsigned char* lds, const Gemm g, const Sched& S, const Epi& E) {
    const int tid = fresh_tid(), wid = __builtin_amdgcn_readfirstlane(tid >> 6), lane = tid & 63, wr = wid >> 2, wc = wid & 3, fr = lane & 15, fq = lane >> 4;
    const int K = g.K, nt = K / BK;
    unsigned voffA[2], voffB[2];
#pragma unroll
    for (int i = 0; i < 2; ++i) { int R, C; stage_rc(tid * 16 + i * 8192, R, C); const int Rb = Epi::PERM ? ((R & ~31) + perm32(R & 31)) : R;
        voffA[i] = (unsigned)(R * K + C) * 2u; voffB[i] = (unsigned)(Rb * K + C) * 2u; }
    const size_t kstep = (size_t)(BK * 2);
    const size_t hstep = (size_t)HALF * K * 2;
    const size_t tstep = 2 * hstep;
    const unsigned ldsw = (unsigned)wid * 1024u;
    const int aoff = lds_byte(wr * 64 + fr, fq * 8), boff = lds_byte(wc * 32 + fr, fq * 8);
#define PG8_SA(b, h) (((b) * 2 + (h)) * HTB)
#define PG8_SB(b, h) ((4 + (b) * 2 + (h)) * HTB)
#define PG8_STAGE(bufoff, gbase, voff) do { _Pragma("unroll") for (int _i = 0; _i < 2; ++_i) \
        __builtin_amdgcn_global_load_lds((const unsigned*)((const char*)(gbase) + (voff)[_i]), (PG8_LAS unsigned*)(lds + (bufoff) + ldsw + _i * 8192), 16, 0, 0); } while (0)
#define PG8_LDA(dst, b, h) do { _Pragma("unroll") for (int m = 0; m < 4; ++m) _Pragma("unroll") for (int k = 0; k < 2; ++k) dst[m][k] = *(const PG8_LAS bf16x8*)(lds + PG8_SA(b, h) + aoff + m * 2048 + k * 1024); } while (0)
#define PG8_LDB(dst, b, h) do { _Pragma("unroll") for (int n = 0; n < 2; ++n) _Pragma("unroll") for (int k = 0; k < 2; ++k) dst[n][k] = *(const PG8_LAS bf16x8*)(lds + PG8_SB(b, h) + boff + n * 2048 + k * 1024); } while (0)
#define PG8_MMA(ai, bj, At, Bt) do { __builtin_amdgcn_s_setprio(1); _Pragma("unroll") for (int m = 0; m < 4; ++m) _Pragma("unroll") for (int n = 0; n < 2; ++n) _Pragma("unroll") for (int k = 0; k < 2; ++k) \
        acc[ai][bj][m][n] = __builtin_amdgcn_mfma_f32_16x16x32_bf16(Bt[n][k], At[m][k], acc[ai][bj][m][n], 0, 0, 0); __builtin_amdgcn_s_setprio(0); } while (0)
#define PG8_WAIT_V(n) asm volatile("s_waitcnt vmcnt(" #n ")" ::: "memory")
#define PG8_WAIT_L(n) asm volatile("s_waitcnt lgkmcnt(" #n ")" ::: "memory")
#define PG8_BAR __builtin_amdgcn_s_barrier()
#define PG8_SCHED __builtin_amdgcn_sched_barrier(0)
    Unit cur, nxt; int ui = 0;
    if (!S.next(0, cur)) return;
    f32x4 acc[2][2][4][2];
#pragma unroll
    for (int a = 0; a < 2; ++a)
#pragma unroll
        for (int b = 0; b < 2; ++b)
#pragma unroll
            for (int m = 0; m < 4; ++m)
#pragma unroll
                for (int n = 0; n < 2; ++n) acc[a][b][m][n] = (f32x4){0.f, 0.f, 0.f, 0.f};
    bf16x8 At[4][2], B0[2][2], B1[2][2];
    const char* cA = (const char*)g.A + (size_t)cur.pm * tstep; const char* cB = (const char*)g.Bt + (size_t)cur.pn * tstep;
    S.a_ready(cur);
    if constexpr (SP2) {
        PG8_STAGE(PG8_SB(0, 0), cB, voffB); PG8_STAGE(PG8_SB(0, 1), cB + hstep, voffB); PG8_STAGE(PG8_SA(0, 0), cA, voffA); PG8_STAGE(PG8_SA(0, 1), cA + hstep, voffA);
        if (wr == 1) PG8_BAR;
        PG8_WAIT_V(2); PG8_BAR;
        PG8_STAGE(PG8_SB(1, 0), cB + kstep, voffB); PG8_STAGE(PG8_SA(1, 0), cA + kstep, voffA); PG8_STAGE(PG8_SB(1, 1), cB + hstep + kstep, voffB);
        PG8_WAIT_V(6); PG8_BAR;
    } else {
        PG8_STAGE(PG8_SB(0, 0), cB, voffB); PG8_STAGE(PG8_SA(0, 0), cA, voffA); PG8_STAGE(PG8_SB(0, 1), cB + hstep, voffB); PG8_STAGE(PG8_SA(0, 1), cA + hstep, voffA);
        if (wr == 1) PG8_BAR;
        PG8_WAIT_V(4); PG8_BAR;
        PG8_STAGE(PG8_SB(1, 0), cB + kstep, voffB); PG8_STAGE(PG8_SA(1, 0), cA + kstep, voffA); PG8_STAGE(PG8_SB(1, 1), cB + hstep + kstep, voffB);
        PG8_WAIT_V(6); PG8_BAR;
    }
    for (;;) {
        const bool has_next = S.next(ui + 1, nxt);
        const char* nA = has_next ? (const char*)g.A + (size_t)nxt.pm * tstep : cA; const char* nB = has_next ? (const char*)g.Bt + (size_t)nxt.pn * tstep : cB;
        for (int t = 0; t < nt; t += 2) {
            const bool last = (t == nt - 2);
            const char* a1 = cA + (size_t)(t + 1) * kstep;
            const char* a2 = last ? nA : cA + (size_t)(t + 2) * kstep; const char* b2 = last ? nB : cB + (size_t)(t + 2) * kstep;
            const char* a3 = a2 + kstep; const char* b3 = b2 + kstep;
            if (last && has_next) S.a_ready(nxt);
            if constexpr (SP2) {
            PG8_LDB(B0, 0, 0); PG8_LDB(B1, 0, 1); PG8_SCHED; PG8_LDA(At, 0, 0); PG8_STAGE(PG8_SA(1, 1), a1 + hstep, voffA);
            PG8_WAIT_V(8); PG8_WAIT_L(0); PG8_BAR; PG8_MMA(0, 0, At, B0); PG8_MMA(0, 1, At, B1); PG8_BAR; PG8_SCHED;
            PG8_LDA(At, 0, 1); PG8_STAGE(PG8_SB(0, 0), b2, voffB); PG8_STAGE(PG8_SB(0, 1), b2 + hstep, voffB); PG8_STAGE(PG8_SA(0, 0), a2, voffA);
            PG8_WAIT_V(8); PG8_WAIT_L(0); PG8_BAR; PG8_MMA(1, 0, At, B0); PG8_MMA(1, 1, At, B1); PG8_BAR; PG8_SCHED;
            PG8_LDB(B0, 1, 0); PG8_LDB(B1, 1, 1); PG8_SCHED; PG8_LDA(At, 1, 0); PG8_STAGE(PG8_SA(0, 1), a2 + hstep, voffA);
            PG8_WAIT_V(8); PG8_WAIT_L(0); PG8_BAR; PG8_MMA(0, 0, At, B0); PG8_MMA(0, 1, At, B1); PG8_BAR; PG8_SCHED;
            PG8_LDA(At, 1, 1); PG8_STAGE(PG8_SB(1, 0), b3, voffB); PG8_STAGE(PG8_SB(1, 1), b3 + hstep, voffB); PG8_STAGE(PG8_SA(1, 0), a3, voffA);
            PG8_WAIT_V(8); PG8_WAIT_L(0); PG8_BAR; PG8_MMA(1, 0, At, B0); PG8_MMA(1, 1, At, B1); PG8_BAR; PG8_SCHED;
            } else {
            PG8_LDB(B0, 0, 0); PG8_SCHED; PG8_LDA(At, 0, 0); PG8_STAGE(PG8_SA(1, 1), a1 + hstep, voffA);
            PG8_WAIT_L(8); PG8_BAR; PG8_WAIT_L(0); PG8_MMA(0, 0, At, B0); PG8_BAR; PG8_SCHED;
            PG8_LDB(B1, 0, 1); PG8_STAGE(PG8_SB(0, 0), b2, voffB);
            PG8_BAR; PG8_WAIT_L(0); PG8_MMA(0, 1, At, B1); PG8_BAR;
            PG8_LDA(At, 0, 1); PG8_STAGE(PG8_SA(0, 0), a2, voffA);
            PG8_BAR; PG8_WAIT_L(0); PG8_MMA(1, 0, At, B0); PG8_BAR; PG8_SCHED;
            PG8_STAGE(PG8_SB(0, 1), b2 + hstep, voffB);
            PG8_WAIT_V(6); PG8_BAR; PG8_MMA(1, 1, At, B1); PG8_BAR;
            PG8_LDB(B0, 1, 0); PG8_SCHED; PG8_LDA(At, 1, 0); PG8_STAGE(PG8_SA(0, 1), a2 + hstep, voffA);
            PG8_WAIT_L(8); PG8_BAR; PG8_WAIT_L(0); PG8_MMA(0, 0, At, B0); PG8_BAR; PG8_SCHED;
            PG8_LDB(B1, 1, 1); PG8_STAGE(PG8_SB(1, 0), b3, voffB);
            PG8_BAR; PG8_WAIT_L(0); PG8_MMA(0, 1, At, B1); PG8_BAR;
            PG8_LDA(At, 1, 1); PG8_STAGE(PG8_SA(1, 0), a3, voffA);
            PG8_BAR; PG8_WAIT_L(0); PG8_MMA(1, 0, At, B0); PG8_BAR; PG8_SCHED;
            PG8_STAGE(PG8_SB(1, 1), b3 + hstep, voffB);
            PG8_WAIT_V(6); PG8_BAR; PG8_MMA(1, 1, At, B1); PG8_BAR;
            }
        }
        if constexpr (ALIGN_EPI) { if (wr == 0) PG8_BAR; }
        if constexpr (!Epi::AFTER_DRAIN) { E(acc, cur, wr, wc, fr, fq); S.done(cur); }
        if (!has_next) break;
#pragma unroll
        for (int a = 0; a < 2; ++a)
#pragma unroll
            for (int b = 0; b < 2; ++b)
#pragma unroll
                for (int m = 0; m < 4; ++m)
#pragma unroll
                    for (int n = 0; n < 2; ++n) acc[a][b][m][n] = (f32x4){0.f, 0.f, 0.f, 0.f};
        cur = nxt; cA = nA; cB = nB; ++ui;
        if constexpr (ALIGN_EPI) { if (wr == 1) PG8_BAR; }
    }
    PG8_WAIT_V(0);
    if constexpr (!ALIGN_EPI) { if (wr == 0) PG8_BAR; }
    PG8_BAR;
    if constexpr (Epi::AFTER_DRAIN) { E.fused(acc, cur, wr, wc, fr, fq, lds, wid, lane); S.done(cur); }
#undef PG8_SA
#undef PG8_SB
#undef PG8_STAGE
#undef PG8_LDA
#undef PG8_LDB
#undef PG8_MMA
#undef PG8_WAIT_V
#undef PG8_WAIT_L
#undef PG8_BAR
#undef PG8_SCHED
}
}
#include <hip/hip_bf16.h>
#include <cmath>
namespace attn_body {
using bf16=__hip_bfloat16;
using bf16x8=__attribute__((ext_vector_type(8)))short;
using s16x4=__attribute__((ext_vector_type(4)))short;
using f32x16=__attribute__((ext_vector_type(16)))float;
using u32x4=__attribute__((ext_vector_type(4)))unsigned;
constexpr int BATCH=2,NHEAD=16,SEQ=8192,D=64,DM=NHEAD*D;
constexpr int NW=8,QBLK=32,QB=QBLK*NW,KVBLK=64,NQB=SEQ/QB;
constexpr int ATTN_PITCH=DM, ATTN_UNIT_ROWS=QB;
__device__ __forceinline__ int crow(int r,int hi){return (r&3)+8*(r>>2)+4*hi;}
#define SBAR() __builtin_amdgcn_sched_barrier(0)
__device__ __forceinline__ void cmask(f32x16&p0,f32x16&p1,int jb,int qrel,int hi){
  const float NEG=-INFINITY; int kb=64*jb+4*hi;
  #pragma unroll
  for(int r=0;r<16;++r){int kv=kb+(r&3)+8*(r>>2); if(kv>qrel)p0[r]=NEG; if(kv+32>qrel)p1[r]=NEG;}
}

constexpr int NSLOT=3, SLOTB=8192;
constexpr int LDS_K=0, LDS_V=NSLOT*SLOTB, LDS_WS=2*NSLOT*SLOTB, LDS_OST=LDS_WS+NW*64*4, LDS_BYTES=LDS_OST+NW*4096;
constexpr float C2=0.125f*1.4426950408889634f;
__device__ __forceinline__ void glds16(const void*gsrc,unsigned lds_dst){unsigned keep;
  asm volatile("s_mov_b32 %0, m0\n\ts_mov_b32 m0, %2\n\ts_nop 0\n\tglobal_load_lds_dwordx4 %1, off\n\ts_mov_b32 m0, %0":"=&s"(keep):"v"(gsrc),"s"(lds_dst):"memory");}
__device__ __forceinline__ float max3f(float a,float b,float c){float r;asm("v_max3_f32 %0, %1, %2, %3":"=v"(r):"v"(a),"v"(b),"v"(c));return r;}
__device__ __forceinline__ float max2f(float a,float b){float r;asm("v_max_f32_e32 %0, %1, %2":"=v"(r):"v"(a),"v"(b));return r;}
__device__ __forceinline__ float fadd_s(float a,float b){float r;asm("v_add_f32_e32 %0, %1, %2":"=v"(r):"v"(a),"v"(b));return r;}
__device__ __forceinline__ float fsub_s(float a,float b){float r;asm("v_sub_f32_e32 %0, %1, %2":"=v"(r):"v"(a),"v"(b));return r;}
typedef float f32x2_t __attribute__((ext_vector_type(2))); typedef __bf16 bf16x2_t __attribute__((ext_vector_type(2)));
__device__ __forceinline__ unsigned cvtpk_s(float lo,float hi){f32x2_t v={lo,hi};bf16x2_t b=__builtin_convertvector(v,bf16x2_t);return __builtin_bit_cast(unsigned,b);}
#define WAIT_BAR(N) asm volatile("s_waitcnt vmcnt(" #N ") lgkmcnt(0)\n\ts_barrier":::"memory")

__device__ __forceinline__ void qkt(f32x16&p0,f32x16&p1,const char*Kslot,const bf16x8*qr,const f32x16&negm,int r32,int hi){
  const char*kb=Kslot+hi*1024+r32*16;
  #pragma unroll
  for(int d0=0;d0<4;++d0){
    const bf16x8 b0=*reinterpret_cast<const bf16x8*>(kb+d0*2048);
    const bf16x8 b1=*reinterpret_cast<const bf16x8*>(kb+d0*2048+512);
    if(d0==0){p0=__builtin_amdgcn_mfma_f32_32x32x16_bf16(b0,qr[0],negm,0,0,0);p1=__builtin_amdgcn_mfma_f32_32x32x16_bf16(b1,qr[0],negm,0,0,0);}
    else{p0=__builtin_amdgcn_mfma_f32_32x32x16_bf16(b0,qr[d0],p0,0,0,0);p1=__builtin_amdgcn_mfma_f32_32x32x16_bf16(b1,qr[d0],p1,0,0,0);}}
}
typedef __attribute__((address_space(3))) const char* lds_cptr;
typedef short v4i16_t __attribute__((ext_vector_type(4)));
__device__ __forceinline__ void kload8(bf16x8*kf,lds_cptr kp){
  kf[0]=*(const __attribute__((address_space(3))) bf16x8*)(kp);      kf[1]=*(const __attribute__((address_space(3))) bf16x8*)(kp+512);
  kf[2]=*(const __attribute__((address_space(3))) bf16x8*)(kp+2048); kf[3]=*(const __attribute__((address_space(3))) bf16x8*)(kp+2560);
  kf[4]=*(const __attribute__((address_space(3))) bf16x8*)(kp+4096); kf[5]=*(const __attribute__((address_space(3))) bf16x8*)(kp+4608);
  kf[6]=*(const __attribute__((address_space(3))) bf16x8*)(kp+6144); kf[7]=*(const __attribute__((address_space(3))) bf16x8*)(kp+6656);
}
__device__ __forceinline__ void kload2(bf16x8*kf,lds_cptr kp,int j){ kf[2*j]=*(const __attribute__((address_space(3))) bf16x8*)(kp+j*2048); kf[2*j+1]=*(const __attribute__((address_space(3))) bf16x8*)(kp+j*2048+512); }
__device__ __forceinline__ s16x4 vtr(lds_cptr p){ return __builtin_bit_cast(s16x4,__builtin_amdgcn_ds_read_tr16_b64_v4i16((__attribute__((address_space(3))) v4i16_t*)p)); }
__device__ __forceinline__ float rowmax(const f32x16&p0,const f32x16&p1){
  float a=max3f(p0[0],p0[1],p1[0]),b=max3f(p0[2],p0[3],p1[1]);a=max3f(a,p1[2],p1[3]);
  #pragma unroll
  for(int r=4;r<16;r+=4){a=max3f(a,p0[r],p0[r+1]);b=max3f(b,p0[r+2],p0[r+3]);a=max3f(a,p1[r],p1[r+1]);b=max3f(b,p1[r+2],p1[r+3]);}
  const float m=max2f(a,b);
  auto rr=__builtin_amdgcn_permlane32_swap(__float_as_uint(m),__float_as_uint(m),false,false);
  return max2f(__uint_as_float(rr[0]),__uint_as_float(rr[1]));
}
__device__ __forceinline__ void pv(f32x16*o,int vb,bf16x8 pa0,bf16x8 pa1,bf16x8 pa2,bf16x8 pa3){
  #pragma unroll
  for(int d0=0;d0<2;++d0){s16x4 lo[4],hi[4];
    #pragma unroll
    for(int ks=0;ks<4;++ks){
      asm volatile("ds_read_b64_tr_b16 %0,%1 offset:%c2":"=&v"(lo[ks]):"v"(vb),"i"(d0*4096+ks*1024):"memory");
      asm volatile("ds_read_b64_tr_b16 %0,%1 offset:%c2":"=&v"(hi[ks]):"v"(vb),"i"(d0*4096+ks*1024+512):"memory");}
    asm volatile("s_waitcnt lgkmcnt(0)":::"memory");SBAR();
    #define PK(k) (bf16x8){lo[k][0],lo[k][1],lo[k][2],lo[k][3],hi[k][0],hi[k][1],hi[k][2],hi[k][3]}
    o[d0]=__builtin_amdgcn_mfma_f32_32x32x16_bf16(pa0,PK(0),o[d0],0,0,0);
    o[d0]=__builtin_amdgcn_mfma_f32_32x32x16_bf16(pa1,PK(1),o[d0],0,0,0);
    o[d0]=__builtin_amdgcn_mfma_f32_32x32x16_bf16(pa2,PK(2),o[d0],0,0,0);
    o[d0]=__builtin_amdgcn_mfma_f32_32x32x16_bf16(pa3,PK(3),o[d0],0,0,0);
    #undef PK
  }
}

#ifndef ATTN_STORE16
#define ATTN_STORE16(p,v) (*(u32x4*)(p)=(v))
#endif
template<int THRL> __device__ __forceinline__ void attn_unit(int b,int h,int hv,int qb,const bf16*Q,const bf16*__restrict__ K,const bf16*__restrict__ V,bf16*O,char*shm){
  const int tid=fresh_tid(),lane=tid&63,r32=lane&31,hi=lane>>5; const int wid=__builtin_amdgcn_readfirstlane(tid>>6);
  const long rowbase=(long)b*SEQ; const int q0=qb*QB;
  const bf16*Qw=Q+(rowbase+q0+wid*QBLK)*DM+h*D;
  const bf16*Kh=K+rowbase*DM+h*D,*Vh=V+rowbase*DM+hv*D;
  const unsigned lds0=(unsigned)(uintptr_t)shm;
  float*wsf=(float*)(shm+LDS_WS)+wid*64;
  const bf16*ksrc=Kh+(long)lane*DM+wid*8;
  const bf16*vsrc=Vh+(long)(16*(wid&3)+(lane>>2))*DM+(wid>>2)*32+(lane&3)*8;
  const unsigned kdst=lds0+LDS_K+wid*1024, vdst=lds0+LDS_V+wid*1024;
  #define DMA_K(t,slot) glds16(ksrc+(long)(t)*KVBLK*DM,(unsigned)__builtin_amdgcn_readfirstlane(kdst+(slot)))
  #define DMA_V(t,slot) glds16(vsrc+(long)(t)*KVBLK*DM,(unsigned)__builtin_amdgcn_readfirstlane(vdst+(slot)))
  const int vb0=(int)(lds0+LDS_V)+((lane>>4)&1)*32+(lane&3)*8+(4*hi+((lane&15)>>2))*64;
  const char*Kbase=shm+LDS_K; bf16x8 kf[8];
  const lds_cptr shm3=(lds_cptr)shm; const lds_cptr kp0=shm3+LDS_K+hi*1024+r32*16; const lds_cptr vp0=shm3+LDS_V+((lane>>4)&1)*32+(lane&3)*8+(4*hi+((lane&15)>>2))*64;
  const int NT=(q0+QB)/KVBLK;
  DMA_K(0,0);DMA_V(0,0);DMA_K(1,SLOTB);
  bf16x8 qr[4];
  #pragma unroll
  for(int d0=0;d0<4;++d0)qr[d0]=*reinterpret_cast<const bf16x8*>(&Qw[(long)r32*DM+d0*16+hi*8]);
  float mhat=0.f,l_reg=0.f;f32x16 o[2];o[0]=f32x16{};o[1]=f32x16{};f32x16 negm=f32x16{};asm volatile("":"+v"(negm));
  const int qrel=wid*QBLK+r32;
  #define CMASK(P0,P1,t) do{int jb_=(t)-(NT-4); if(jb_>=0)cmask(P0,P1,jb_,qrel,hi);}while(0)
  bool resc=false;
  #define START(P0,P1) do{ const float rm=rowmax(P0,P1); resc=false; \
    { const float dl=rm; mhat=fadd_s(mhat,dl); \
      _Pragma("unroll") for(int r=0;r<16;++r){P0[r]=fsub_s(P0[r],dl);P1[r]=fsub_s(P1[r],dl);} \
      _Pragma("unroll") for(int r=0;r<16;++r)negm[r]=-mhat; asm volatile("":"+v"(negm)); } \
    _Pragma("unroll") for(int r=0;r<16;++r)P0[r]=__builtin_amdgcn_exp2f(P0[r]); }while(0)
  #define RESC() do{ if(resc){ asm volatile("s_waitcnt lgkmcnt(0)":::"memory"); \
      _Pragma("unroll") for(int d_=0;d_<2;++d_) _Pragma("unroll") for(int r=0;r<16;++r)o[d_][r]*=wsf[crow(r,hi)]; } }while(0)
  f32x16 pA0,pA1,pB0,pB1;
  int sl_prev=0,sl_cur=0,sl_next=SLOTB;
  #define ROT() do{sl_prev=sl_cur;sl_cur=sl_next;sl_next=(sl_next==(NSLOT-1)*SLOTB)?0:sl_next+SLOTB;}while(0)
  DMA_K(2,2*SLOTB);
  WAIT_BAR(3);
  qkt(pA0,pA1,Kbase,qr,negm,r32,hi);asm volatile("s_nop 15\n\ts_nop 7":"+v"(pA0),"+v"(pA1));CMASK(pA0,pA1,0);
  START(pA0,pA1);
  _Pragma("unroll") for(int r=0;r<16;++r)pA1[r]=__builtin_amdgcn_exp2f(pA1[r]);
  WAIT_BAR(0);
  DMA_K(3,0);DMA_V(1,SLOTB);
  ROT();
  kload8(kf,kp0+sl_cur);
  WAIT_BAR(2);
  s16x4 vlo[8],vhi[8]; u32x4 pw0,pw1,pw2,pw3;
  #define PKW(P,B) cvtpk_s(P[B],P[B+1])
  #define PAF(k) __builtin_bit_cast(bf16x8,pw##k)
  #define VFR(i) (bf16x8){vlo[i][0],vlo[i][1],vlo[i][2],vlo[i][3],vhi[i][0],vhi[i][1],vhi[i][2],vhi[i][3]}
  #define PIN(x) asm volatile("":"+v"(x))
  #define MX3(a,b,c) __builtin_fmaxf(__builtin_fmaxf((a),(b)),(c))
  #define GAPA(MF,A0,A1,A2,A3,W0,W1,PW) do{ MF; sacc+=A0; sacc+=A1; sacc+=A2; sacc+=A3; PIN(sacc); W0; W1; PIN(PW); SBAR(); }while(0)
  #define EX(v) __builtin_amdgcn_exp2f(v)
  #define GAPB(MF,X,B) do{ MF; X[B]=EX(X[B]); X[B+1]=EX(X[B+1]); X[B+2]=EX(X[B+2]); X[B+3]=EX(X[B+3]); PIN(X); SBAR(); }while(0)
  #define VRD(i) do{ vlo[i]=vtr(vp_+(((i)>>2)*4096+((i)&3)*1024)); vhi[i]=vtr(vp_+(((i)>>2)*4096+((i)&3)*1024+512)); }while(0)
  #define KRD(G,j) do{ if(G){ kload2(kf,kp0+sl_next,j); SBAR(); } }while(0)
  #define STEP(C0,C1,P0,P1,t,GK,GV,GL) do{ SBAR(); \
    const lds_cptr vp_=vp0+sl_prev; \
    VRD(0); SBAR(); float sacc=(P0[0]+P0[1]); \
    GAPA(C0=__builtin_amdgcn_mfma_f32_32x32x16_bf16(kf[0],qr[0],negm,0,0,0), P0[2],P0[3],P0[4],P0[5],     pw0[0]=PKW(P0,0), pw0[1]=PKW(P0,2), pw0); \
    VRD(4); SBAR(); GAPA(C1=__builtin_amdgcn_mfma_f32_32x32x16_bf16(kf[1],qr[0],negm,0,0,0), P0[6],P0[7],P0[8],P0[9],     pw0[2]=PKW(P0,4), pw0[3]=PKW(P0,6), pw0); \
    VRD(1); SBAR(); GAPA(C0=__builtin_amdgcn_mfma_f32_32x32x16_bf16(kf[2],qr[1],C0,0,0,0),   P0[10],P0[11],P0[12],P0[13], pw1[0]=PKW(P0,8), pw1[1]=PKW(P0,10), pw1); \
    VRD(5); SBAR(); GAPA(C1=__builtin_amdgcn_mfma_f32_32x32x16_bf16(kf[3],qr[1],C1,0,0,0),   P0[14],P0[15],P1[0],P1[1],   pw1[2]=PKW(P0,12),pw1[3]=PKW(P0,14), pw1); \
    VRD(2); SBAR(); GAPA(C0=__builtin_amdgcn_mfma_f32_32x32x16_bf16(kf[4],qr[2],C0,0,0,0),   P1[2],P1[3],P1[4],P1[5],     pw2[0]=PKW(P1,0), pw2[1]=PKW(P1,2), pw2); \
    VRD(6); SBAR(); GAPA(C1=__builtin_amdgcn_mfma_f32_32x32x16_bf16(kf[5],qr[2],C1,0,0,0),   P1[6],P1[7],P1[8],P1[9],     pw2[2]=PKW(P1,4), pw2[3]=PKW(P1,6), pw2); \
    VRD(3); SBAR(); GAPA(C0=__builtin_amdgcn_mfma_f32_32x32x16_bf16(kf[6],qr[3],C0,0,0,0),   P1[10],P1[11],P1[12],P1[13], pw3[0]=PKW(P1,8), pw3[1]=PKW(P1,10), pw3); \
    VRD(7); SBAR(); GAPA(C1=__builtin_amdgcn_mfma_f32_32x32x16_bf16(kf[7],qr[3],C1,0,0,0),   P1[14],P1[15],0.f,0.f,       pw3[2]=PKW(P1,12),pw3[3]=PKW(P1,14), pw3); \
    l_reg+=sacc; \
    if(GK){DMA_K((t)+3,sl_cur);} if(GV){DMA_V((t)+1,sl_next);} \
    CMASK(C0,C1,t); \
    { float a=MX3(C0[0],C0[1],C1[0]),b=MX3(C0[2],C0[3],C1[1]); a=MX3(a,C1[2],C1[3]); \
      _Pragma("unroll") for(int r=4;r<16;r+=4){a=MX3(a,C0[r],C0[r+1]);b=MX3(b,C0[r+2],C0[r+3]);a=MX3(a,C1[r],C1[r+1]);b=MX3(b,C1[r+2],C1[r+3]);} \
      float rm=__builtin_fmaxf(a,b); { auto rr=__builtin_amdgcn_permlane32_swap(__float_as_uint(rm),__float_as_uint(rm),false,false); rm=__builtin_fmaxf(__uint_as_float(rr[0]),__uint_as_float(rr[1])); } \
      resc=false; \
      if(__builtin_expect(__any(rm>(float)THRL),0)){ const float dl=__builtin_fmaxf(rm,0.f); mhat+=dl; \
        _Pragma("unroll") for(int r=0;r<16;++r){C0[r]-=dl;C1[r]-=dl;} \
        _Pragma("unroll") for(int r=0;r<16;++r)negm[r]=-mhat; asm volatile("":"+v"(negm)); \
        const float f=__builtin_amdgcn_exp2f(-dl); l_reg*=f; if(hi==0)wsf[r32]=f; resc=true; } } \
    SBAR(); \
    GAPB(o[0]=__builtin_amdgcn_mfma_f32_32x32x16_bf16(PAF(0),VFR(0),o[0],0,0,0), C0,0); \
    GAPB(o[1]=__builtin_amdgcn_mfma_f32_32x32x16_bf16(PAF(0),VFR(4),o[1],0,0,0), C0,4); \
    KRD(GL,0); GAPB(o[0]=__builtin_amdgcn_mfma_f32_32x32x16_bf16(PAF(1),VFR(1),o[0],0,0,0), C0,8); \
    KRD(GL,1); GAPB(o[1]=__builtin_amdgcn_mfma_f32_32x32x16_bf16(PAF(1),VFR(5),o[1],0,0,0), C0,12); \
    KRD(GL,2); GAPB(o[0]=__builtin_amdgcn_mfma_f32_32x32x16_bf16(PAF(2),VFR(2),o[0],0,0,0), C1,0); \
    KRD(GL,3); GAPB(o[1]=__builtin_amdgcn_mfma_f32_32x32x16_bf16(PAF(2),VFR(6),o[1],0,0,0), C1,4); \
    GAPB(o[0]=__builtin_amdgcn_mfma_f32_32x32x16_bf16(PAF(3),VFR(3),o[0],0,0,0), C1,8); \
    GAPB(o[1]=__builtin_amdgcn_mfma_f32_32x32x16_bf16(PAF(3),VFR(7),o[1],0,0,0), C1,12); \
    }while(0)
  int t=1;
  #undef CMASK
  #define CMASK(P0,P1,t) do{}while(0)
  for(;t+5<NT;t+=2){
    STEP(pB0,pB1,pA0,pA1,t,true,true,true);     WAIT_BAR(2); RESC(); ROT();
    STEP(pA0,pA1,pB0,pB1,t+1,true,true,true);   WAIT_BAR(2); RESC(); ROT();
  }
  #undef CMASK
  #define CMASK(P0,P1,t) do{int jb_=(t)-(NT-4); if(jb_>=0)cmask(P0,P1,jb_,qrel,hi);}while(0)
  #define ENDW(tt) do{ if((tt)+3<NT){WAIT_BAR(2);} else if((tt)+2<NT){WAIT_BAR(1);} else {WAIT_BAR(0);} }while(0)
  for(;t+1<NT;t+=2){
    STEP(pB0,pB1,pA0,pA1,t,(t+3<NT),(t+1<NT),(t+1<NT));       ENDW(t);   RESC(); ROT();
    STEP(pA0,pA1,pB0,pB1,t+1,(t+4<NT),(t+2<NT),(t+2<NT));     ENDW(t+1); RESC(); ROT();
  }
  STEP(pB0,pB1,pA0,pA1,NT-1,false,false,false); RESC();
  { float sacc=pB0[0]+pB0[1]; _Pragma("unroll") for(int r=2;r<16;++r)sacc+=pB0[r]; _Pragma("unroll") for(int r=0;r<16;++r)sacc+=pB1[r]; l_reg+=sacc;
    pw0=(u32x4){PKW(pB0,0),PKW(pB0,2),PKW(pB0,4),PKW(pB0,6)};pw1=(u32x4){PKW(pB0,8),PKW(pB0,10),PKW(pB0,12),PKW(pB0,14)};pw2=(u32x4){PKW(pB1,0),PKW(pB1,2),PKW(pB1,4),PKW(pB1,6)};pw3=(u32x4){PKW(pB1,8),PKW(pB1,10),PKW(pB1,12),PKW(pB1,14)};
    SBAR(); pv(o,vb0+sl_cur,PAF(0),PAF(1),PAF(2),PAF(3)); }
  #undef PKW
  #undef PAF
  #undef VFR
  #undef PIN
  #undef MX3
  #undef GAPA
  #undef GAPB
  #undef EX
  #undef VRD
  #undef KRD
  #undef STEP
  #undef ENDW
  {auto rr=__builtin_amdgcn_permlane32_swap(__float_as_uint(l_reg),__float_as_uint(l_reg),false,false);l_reg=__uint_as_float(rr[0])+__uint_as_float(rr[1]);}
  if(hi==0)wsf[32+r32]=l_reg;asm volatile("s_waitcnt lgkmcnt(0)":::"memory");
  float rli[16];
  #pragma unroll
  for(int r=0;r<16;++r)rli[r]=__builtin_amdgcn_rcpf(wsf[32+crow(r,hi)]);
  bf16*Ow=O+(rowbase+q0+wid*QBLK)*DM+hv*D;
  { bf16*stg=(bf16*)(shm+LDS_OST)+wid*2048;
    #pragma unroll
    for(int r=0;r<16;++r){const int orow=crow(r,hi);
      #pragma unroll
      for(int d0=0;d0<2;++d0)stg[orow*64+d0*32+r32]=__float2bfloat16(o[d0][r]*rli[r]);}
    asm volatile("s_waitcnt lgkmcnt(0)":::"memory");
    #pragma unroll
    for(int i=0;i<4;++i){const int row=i*8+(lane>>3),ch=lane&7; const u32x4 v=*(const u32x4*)(stg+row*64+ch*8); ATTN_STORE16(Ow+(long)row*DM+ch*8,v);} }
  asm volatile("s_waitcnt lgkmcnt(0)\n\ts_barrier":::"memory");
  #undef DMA_K
  #undef DMA_V
  #undef CMASK
  #undef START
  #undef RESC
  #undef ROT
}
constexpr int ATTN_LDS_BYTES=LDS_BYTES;
#undef SBAR
#undef WAIT_BAR
}
#define LAS __attribute__((address_space(3)))
typedef unsigned short bf16;
typedef unsigned v4u __attribute__((ext_vector_type(4)));
typedef float f32x4 __attribute__((ext_vector_type(4)));
typedef float f32x16 __attribute__((ext_vector_type(16)));
typedef short bf16x8 __attribute__((ext_vector_type(8)));
constexpr int NWAVES = 8, NTHR = 512;
constexpr int NB = 4, SEQ = 8192, DM = 1024, TT = NB * SEQ, TH = 16384, FF = 4096, NIN = 9216;
constexpr float EPS = 1e-6f;
constexpr size_t MiB = 1u << 20;
constexpr size_t WS_ADA = 0, WS_ROPE = 1 * MiB, WS_BAR = 3 * MiB, WS_WIN = 4 * MiB, WS_WPA = 22 * MiB, WS_WPR = 24 * MiB, WS_WOUT = 26 * MiB, WS_W1 = 28 * MiB, WS_W2 = 36 * MiB;
constexpr size_t WS_XN = 44 * MiB, WS_Y = 108 * MiB, WS_P = 172 * MiB, WS_DEC = 460 * MiB, WS_END = 462 * MiB;
constexpr size_t PBUF = (size_t)TH * 1024;
constexpr size_t DO_O0 = 0, DO_O1 = 32 * MiB, DO_UST = 64 * MiB;
constexpr int LDS_BYTES = 147456;

#define LDS_WAIT() asm volatile("s_waitcnt lgkmcnt(0)" ::: "memory")
__device__ __forceinline__ unsigned f2bf(float f) { unsigned u = __builtin_bit_cast(unsigned, f); return (u + 0x7fffu + ((u >> 16) & 1u)) >> 16; }
__device__ __forceinline__ unsigned pk2(float lo, float hi) { return f2bf(lo) | (f2bf(hi) << 16); }
__device__ __forceinline__ float bflo(unsigned w) { return __uint_as_float(w << 16); }
__device__ __forceinline__ float bfhi(unsigned w) { return __uint_as_float(w & 0xffff0000u); }
__device__ __forceinline__ float wave_sum(float v) {
#pragma unroll
    for (int o = 1; o < 64; o <<= 1) v += __shfl_xor(v, o);
    return v;
}
struct Args { const float* in[21]; const int* pos; float* out; unsigned char* ws; };

__device__ __forceinline__ void p0_transpose_item(const float* W, int K, int N, bf16* WT, LAS float* scr, int item, int lane) {
    const int nblk = N / 32, kb = item / nblk, nb = item % nblk, k0 = 64 * kb, n0 = 32 * nb;
#pragma unroll 8
    for (int i = 0; i < 32; ++i) { const int kk = 2 * i + (lane >> 5); scr[kk * 33 + (lane & 31)] = W[(size_t)(k0 + kk) * N + n0 + (lane & 31)]; }
    LDS_WAIT(); asm volatile("" ::: "memory");
    const int c = lane & 7;
#pragma unroll
    for (int j = 0; j < 4; ++j) { const int n = (lane >> 3) + 8 * j; const LAS float* s = scr + (8 * c) * 33 + n;
        v4u o; o.x = pk2(s[0 * 33], s[1 * 33]); o.y = pk2(s[2 * 33], s[3 * 33]); o.z = pk2(s[4 * 33], s[5 * 33]); o.w = pk2(s[6 * 33], s[7 * 33]);
        *(v4u*)(WT + (size_t)(n0 + n) * K + k0 + 8 * c) = o; }
    LDS_WAIT(); asm volatile("" ::: "memory");
}

__device__ __forceinline__ void norm_mod_row(const float* xrow, const float* w, const float* sc, const float* sh, bf16* orow, int lane) {
    const f32x4* xr = (const f32x4*)xrow + lane;
    f32x4 v[4]; float s = 0.f;
#pragma unroll
    for (int j = 0; j < 4; ++j) { v[j] = xr[64 * j]; s += (v[j].x * v[j].x + v[j].y * v[j].y) + (v[j].z * v[j].z + v[j].w * v[j].w); }
    const float rinv = 1.0f / sqrtf(wave_sum(s) * (1.f / 1024.f) + EPS);
    unsigned long long* o8 = (unsigned long long*)orow + lane;
#pragma unroll
    for (int j = 0; j < 4; ++j) {
        const f32x4 wv = ((const f32x4*)w)[lane + 64 * j], scv = ((const f32x4*)sc)[lane + 64 * j], shv = ((const f32x4*)sh)[lane + 64 * j];
        const f32x4 o = v[j] * rinv * wv * (scv + 1.0f) + shv;
        o8[64 * j] = (unsigned long long)pk2(o.x, o.y) | ((unsigned long long)pk2(o.z, o.w) << 32);
    }
}

#define XB_TMO      128
#define XB_XCNT(j)  (256  + 64 * (j))
#define XB_XSUB(j)  (1280 + 64 * (j))
#define XB_XGEN(j)  (2304 + 64 * (j))
#define XB_TOP      3328
#define XB_TOPGEN   3392
#define XCD_BAR_WORDS 3456
#define XB_SPIN_CAP (1u << 18)

__device__ __forceinline__ unsigned xb_ld(unsigned* p)              { return __hip_atomic_load(p, __ATOMIC_RELAXED, __HIP_MEMORY_SCOPE_AGENT); }
__device__ __forceinline__ unsigned xb_add(unsigned* p, unsigned v) { return __hip_atomic_fetch_add(p, v, __ATOMIC_RELAXED, __HIP_MEMORY_SCOPE_AGENT); }
__device__ __forceinline__ unsigned xb_xcc_id() { return (unsigned)__builtin_amdgcn_s_getreg((3 << 11) | 20) & 0xFu; }
#define XB_SPIN(cond, bar) do { unsigned _sp = 0; while (cond) { __builtin_amdgcn_s_sleep(1); \
    if ((++_sp & 255u) == 0u) { if (xb_ld(&(bar)[XB_TMO])) break; if (_sp > XB_SPIN_CAP) { atomicAdd(&(bar)[XB_TMO], 1u); break; } } } } while (0)

struct XcdBarrier {
    unsigned* bar; unsigned x;
    volatile LAS unsigned* st;
};

__device__ __forceinline__ XcdBarrier xcd_barrier_post(unsigned* bar, volatile LAS unsigned* st) {
    XcdBarrier b; b.bar = bar; b.x = xb_xcc_id(); b.st = st;
    if (threadIdx.x == 0) (void)xb_add(&bar[XB_XCNT(b.x)], 1u);
    return b;
}
__device__ __forceinline__ void xcd_barrier_complete(unsigned* bar, unsigned x, unsigned& nloc, unsigned& nx) {
    const unsigned G = gridDim.x * gridDim.y * gridDim.z;
    unsigned sum, cnt, mine, sp = 0u;
    for (;;) {
        sum = 0u; cnt = 0u; mine = 0u;
#pragma unroll
        for (unsigned j = 0; j < 16; ++j) { const unsigned c = xb_ld(&bar[XB_XCNT(j)]); sum += c; cnt += (c > 0u) ? 1u : 0u; mine = (j == x) ? c : mine; }
        if (sum == G) break;
        __builtin_amdgcn_s_sleep(1);
        if ((++sp & 255u) == 0u) { if (xb_ld(&bar[XB_TMO])) break; if (sp > XB_SPIN_CAP) { atomicAdd(&bar[XB_TMO], 1u); break; } }
    }
    nloc = mine > 0u ? mine : 1u; nx = cnt > 0u ? cnt : 1u;
}

__device__ __forceinline__ void xcd_barrier(const XcdBarrier& b) {
    asm volatile("s_waitcnt vmcnt(0)" ::: "memory");
    __syncthreads();
    if (threadIdx.x == 0) {
        unsigned* bar = b.bar; const unsigned bx_ = (unsigned)__builtin_amdgcn_readfirstlane((int)xb_xcc_id());
        __builtin_amdgcn_s_waitcnt(0);
        unsigned nloc = b.st[0], nx = b.st[1];
        if (nloc == 0u) { xcd_barrier_complete(bar, bx_, nloc, nx); b.st[0] = nloc; b.st[1] = nx; }
        const unsigned old = xb_add(&bar[XB_XSUB(bx_)], 1u);
        const unsigned gen = old / nloc;
        if (old + 1u == (gen + 1u) * nloc) {
            __builtin_amdgcn_fence(__ATOMIC_RELEASE, "agent");
            asm volatile("s_waitcnt vmcnt(0)" ::: "memory");
            const unsigned og = xb_add(&bar[XB_TOP], 1u);
            const unsigned tg = og / nx;
            if (og + 1u == (tg + 1u) * nx) xb_add(&bar[XB_TOPGEN], 1u);
            else XB_SPIN(xb_ld(&bar[XB_TOPGEN]) == tg, bar);
            __builtin_amdgcn_fence(__ATOMIC_ACQUIRE, "agent");
            xb_add(&bar[XB_XGEN(bx_)], 1u);
            asm volatile("s_waitcnt vmcnt(0)" ::: "memory");
        } else {
            XB_SPIN(xb_ld(&bar[XB_XGEN(bx_)]) == gen, bar);
            __builtin_amdgcn_fence(__ATOMIC_ACQUIRE, "agent");
            asm volatile("s_waitcnt vmcnt(0)" ::: "memory");
        }
    }
    __syncthreads();
}

constexpr int HG_G = 0, HG_TOT = 33792, HG_QP = 35840, HG_KP = 53248, HG_QPP = 70656, HG_VT = 88064, HG_PP = 106496, HG_RED = 115712;
constexpr int GST = 132;
__device__ __forceinline__ int crow(int r, int hi) { return (r & 3) + 8 * (r >> 2) + 4 * hi; }


__device__ __forceinline__ void ld8(const LAS float* p, float (&o)[8]) { const f32x4 a = *(const LAS f32x4*)p, b = *(const LAS f32x4*)(p + 4); o[0] = a[0]; o[1] = a[1]; o[2] = a[2]; o[3] = a[3]; o[4] = b[0]; o[5] = b[1]; o[6] = b[2]; o[7] = b[3]; }
__device__ __forceinline__ bf16x8 ldsfrag(const LAS unsigned char* p) { return *(const LAS bf16x8*)p; }
__device__ __forceinline__ bf16x8 gather8(const LAS bf16* p, int st) {
    bf16x8 r;
#pragma unroll
    for (int i = 0; i < 8; ++i) r[i] = (short)p[i * st];
    return r;
}
constexpr int RS = 136;

struct HgIn1 { v4u f[2], v[2]; };
__device__ __forceinline__ void hg_load1(HgIn1& L, const bf16* RF, const bf16* RI, int unit, int tid) {
    const int bl = unit >> 10, h = (unit >> 7) & 7, c = unit & 127;
    const size_t off = ((size_t)bl * SEQ + (size_t)c * 64) * 1024 + h * 128 + (size_t)(tid >> 4) * 1024 + (tid & 15) * 8;
#pragma unroll
    for (int p = 0; p < 2; ++p) { L.f[p] = *(const v4u*)(RF + off + (size_t)p * 32 * 1024); L.v[p] = *(const v4u*)(RI + off + (size_t)p * 32 * 1024); }
}
__device__ __forceinline__ void hg_gates2(LAS unsigned char* lds, const v4u (&fw)[2], const float* lbl, int h, int tid, float (&kk)[2][8]) {
    const int r0 = tid >> 4, c8 = (tid & 15) * 8;
    LAS float* G = (LAS float*)(lds + HG_G); LAS float* TOT = (LAS float*)(lds + HG_TOT);
    float lb[8];
#pragma unroll
    for (int i = 0; i < 8; ++i) { const int c = h * 128 + c8 + i; lb[i] = 1.0f / (1.0f + __expf(lbl[c] - lbl[1024 + c])); }
#pragma unroll
    for (int p = 0; p < 2; ++p) {
        const int r = r0 + 32 * p; const v4u w = fw[p];
        float x[8] = {bflo(w.x), bfhi(w.x), bflo(w.y), bfhi(w.y), bflo(w.z), bfhi(w.z), bflo(w.w), bfhi(w.w)};
        float g[8];
#pragma unroll
        for (int i = 0; i < 8; ++i) { const float sg = 1.0f / (1.0f + __expf(-x[i])); const float f = lb[i] + (1.0f - lb[i]) * sg; g[i] = __logf(f); kk[p][i] = (1.0f - lb[i]) * (1.0f - sg); }
        *(LAS f32x4*)(G + r * GST + c8) = (f32x4){g[0], g[1], g[2], g[3]};
        *(LAS f32x4*)(G + r * GST + c8 + 4) = (f32x4){g[4], g[5], g[6], g[7]};
    }
    __syncthreads();
    {
        const int k = tid & 127, seg = tid >> 7; float v[16];
#pragma unroll
        for (int i = 0; i < 16; ++i) v[i] = G[(seg * 16 + i) * GST + k];
#pragma unroll
        for (int i = 1; i < 16; ++i) v[i] += v[i - 1];
        TOT[seg * 128 + k] = v[15];
        __syncthreads();
        float off = 0.f;
#pragma unroll
        for (int s = 0; s < 3; ++s) if (s < seg) off += TOT[s * 128 + k];
#pragma unroll
        for (int i = 0; i < 16; ++i) G[(seg * 16 + i) * GST + k] = v[i] + off;
    }
    __syncthreads();
}

__device__ __forceinline__ void hg_unit_state(LAS unsigned char* lds, const HgIn1& L, const float* lbl, bf16* Ust, float* dec, int unit, int tid) {
    const int h = (unit >> 7) & 7;
    const int r0 = tid >> 4, c8 = (tid & 15) * 8, lane = tid & 63, wid = tid >> 6, r32 = lane & 31, hi = lane >> 5;
    float kk[2][8];
    hg_gates2(lds, L.f, lbl, h, tid, kk);
    const LAS float* G = (const LAS float*)(lds + HG_G);
    float bl8[8]; ld8(G + 63 * GST + c8, bl8);
#pragma unroll
    for (int p = 0; p < 2; ++p) {
        const int r = r0 + 32 * p; float b8[8]; ld8(G + r * GST + c8, b8); float kp[8];
#pragma unroll
        for (int i = 0; i < 8; ++i) kp[i] = kk[p][i] * __expf(bl8[i] - b8[i]);
        *(LAS v4u*)(lds + HG_KP + (r * RS + c8) * 2) = (v4u){pk2(kp[0], kp[1]), pk2(kp[2], kp[3]), pk2(kp[4], kp[5]), pk2(kp[6], kp[7])};
        *(LAS v4u*)(lds + HG_VT + (r * RS + c8) * 2) = L.v[p];
    }
    if (tid < 128) dec[(size_t)unit * 128 + tid] = __expf(G[63 * GST + tid]);
    __syncthreads();
    const int jb = wid >> 1, kb0 = (wid & 1) * 2;
    const LAS bf16* VS = (const LAS bf16*)(lds + HG_VT); const LAS bf16* KS = (const LAS bf16*)(lds + HG_KP);
    f32x16 a0 = {}, a1 = {};
#pragma unroll 1
    for (int ks = 0; ks < 4; ++ks) {
        const int s0 = ks * 16 + hi * 8;
        const bf16x8 av = gather8(VS + s0 * RS + jb * 32 + r32, RS);
        const bf16x8 b0 = gather8(KS + s0 * RS + kb0 * 32 + r32, RS);
        const bf16x8 b1 = gather8(KS + s0 * RS + (kb0 + 1) * 32 + r32, RS);
        a0 = __builtin_amdgcn_mfma_f32_32x32x16_bf16(av, b0, a0, 0, 0, 0);
        a1 = __builtin_amdgcn_mfma_f32_32x32x16_bf16(av, b1, a1, 0, 0, 0);
    }
    LAS bf16* STG = (LAS bf16*)lds;
#pragma unroll
    for (int r = 0; r < 16; ++r) { const int j = jb * 32 + crow(r, hi);
        STG[j * RS + kb0 * 32 + r32] = (bf16)f2bf(a0[r]); STG[j * RS + (kb0 + 1) * 32 + r32] = (bf16)f2bf(a1[r]); }
    __syncthreads();
    bf16* up = Ust + (size_t)unit * 16384;
#pragma unroll
    for (int i = 0; i < 4; ++i) { const int p = tid + 512 * i, j = p >> 4, cc = (p & 15) * 8;
        *(v4u*)(up + j * 128 + cc) = *(const LAS v4u*)(lds + (j * RS + cc) * 2); }
    __syncthreads();
}

struct HgIn3 { v4u q[2], f[2], v[2]; };
struct HgLate3 { v4u g[2], s[8]; };
__device__ __forceinline__ void hg_load3(HgIn3& L, const bf16* RQ, const bf16* RF, const bf16* RI, const bf16* RG, const bf16* Sin, int unit, int tid) {
    const int bl = unit >> 10, h = (unit >> 7) & 7, c = unit & 127;
    const size_t off = ((size_t)bl * SEQ + (size_t)c * 64) * 1024 + h * 128 + (size_t)(tid >> 4) * 1024 + (tid & 15) * 8;
#pragma unroll
    for (int p = 0; p < 2; ++p) { const size_t o = off + (size_t)p * 32 * 1024; L.q[p] = *(const v4u*)(RQ + o); L.f[p] = *(const v4u*)(RF + o); L.v[p] = *(const v4u*)(RI + o); }
}
__device__ __forceinline__ void hg_load3_g(HgLate3& L, const bf16* RG, int unit, int tid) {
    const int bl = unit >> 10, h = (unit >> 7) & 7, c = unit & 127;
    const size_t off = ((size_t)bl * SEQ + (size_t)c * 64) * 1024 + h * 128 + (size_t)(tid >> 4) * 1024 + (tid & 15) * 8;
#pragma unroll
    for (int p = 0; p < 2; ++p) L.g[p] = *(const v4u*)(RG + off + (size_t)p * 32 * 1024);
}
__device__ __forceinline__ void hg_load3_s(HgLate3& L, const bf16* Sin, int unit, int tid) {
    const int lane = tid & 63, wid = tid >> 6, jb = wid >> 1;
    const bf16* sp = Sin + (size_t)unit * 16384 + (size_t)(jb * 32 + (lane & 31)) * 128 + (lane >> 5) * 8;
#pragma unroll
    for (int ks = 0; ks < 8; ++ks) L.s[ks] = *(const v4u*)(sp + ks * 16);
}
__device__ __forceinline__ void hg_unit_out(LAS unsigned char* lds, bf16* RQ, const HgIn3& L, const bf16* RG, const bf16* Sin, const float* lbl, const float* rnw, int unit, int tid) {
    const int bl = unit >> 10, h = (unit >> 7) & 7, c = unit & 127;
    const size_t tile_off = ((size_t)bl * SEQ + (size_t)c * 64) * 1024 + h * 128;
    const int r0 = tid >> 4, c8 = (tid & 15) * 8, lane = tid & 63, wid = tid >> 6, r32 = lane & 31, hi = lane >> 5;
    const int tb = wid & 1, jb = wid >> 1;
    HgLate3 LL;
    float kk[2][8];
    hg_gates2(lds, L.f, lbl, h, tid, kk);
    hg_load3_s(LL, Sin, unit, tid);
    const LAS float* G = (const LAS float*)(lds + HG_G);
    float bm8[8]; ld8(G + 31 * GST + c8, bm8);
#pragma unroll
    for (int p = 0; p < 2; ++p) {
        const int r = r0 + 32 * p; float b8[8]; ld8(G + r * GST + c8, b8);
        const v4u qq = L.q[p];
        const float q8[8] = {bflo(qq.x), bfhi(qq.x), bflo(qq.y), bfhi(qq.y), bflo(qq.z), bfhi(qq.z), bflo(qq.w), bfhi(qq.w)};
        float qp[8], kp[8], qpp[8];
#pragma unroll
        for (int i = 0; i < 8; ++i) { const float e = __expf(b8[i] - bm8[i]); qp[i] = q8[i] * e; kp[i] = kk[p][i] * __expf(bm8[i] - b8[i]); qpp[i] = q8[i] * __expf(b8[i]); }
        *(LAS v4u*)(lds + HG_QP + (r * RS + c8) * 2) = (v4u){pk2(qp[0], qp[1]), pk2(qp[2], qp[3]), pk2(qp[4], qp[5]), pk2(qp[6], qp[7])};
        *(LAS v4u*)(lds + HG_KP + (r * RS + c8) * 2) = (v4u){pk2(kp[0], kp[1]), pk2(kp[2], kp[3]), pk2(kp[4], kp[5]), pk2(kp[6], kp[7])};
        *(LAS v4u*)(lds + HG_QPP + (r * RS + c8) * 2) = (v4u){pk2(qpp[0], qpp[1]), pk2(qpp[2], qpp[3]), pk2(qpp[4], qpp[5]), pk2(qpp[6], qpp[7])};
        *(LAS v4u*)(lds + HG_VT + (r * RS + c8) * 2) = L.v[p];
    }
    __syncthreads();
    if (wid < 4) {
        const int stb = wid & 1, ssb = wid >> 1;
        f32x16 sc = {};
        if (ssb <= stb) {
#pragma unroll
            for (int ks = 0; ks < 8; ++ks) {
                const bf16x8 av = ldsfrag(lds + HG_QP + ((stb * 32 + r32) * RS + ks * 16 + hi * 8) * 2);
                const bf16x8 bv = ldsfrag(lds + HG_KP + ((ssb * 32 + r32) * RS + ks * 16 + hi * 8) * 2);
                sc = __builtin_amdgcn_mfma_f32_32x32x16_bf16(av, bv, sc, 0, 0, 0);
            }
        }
        LAS bf16* PP = (LAS bf16*)(lds + HG_PP);
        const int s = ssb * 32 + r32;
#pragma unroll
        for (int r = 0; r < 16; ++r) { const int t = stb * 32 + crow(r, hi); const float v = (ssb <= stb && s <= t) ? sc[r] : 0.f; PP[t * 72 + s] = (bf16)f2bf(v); }
    }
    __syncthreads();
    hg_load3_g(LL, RG, unit, tid);
    f32x16 o = {};
    const LAS bf16* VS = (const LAS bf16*)(lds + HG_VT);
#pragma unroll
    for (int ks = 0; ks < 4; ++ks) {
        const bf16x8 av = ldsfrag(lds + HG_PP + ((tb * 32 + r32) * 72 + ks * 16 + hi * 8) * 2);
        const bf16x8 bv = gather8(VS + (ks * 16 + hi * 8) * RS + jb * 32 + r32, RS);
        o = __builtin_amdgcn_mfma_f32_32x32x16_bf16(av, bv, o, 0, 0, 0);
    }
#pragma unroll
    for (int ks = 0; ks < 8; ++ks) {
        const bf16x8 av = ldsfrag(lds + HG_QPP + ((tb * 32 + r32) * RS + ks * 16 + hi * 8) * 2);
        o = __builtin_amdgcn_mfma_f32_32x32x16_bf16(av, __builtin_bit_cast(bf16x8, LL.s[ks]), o, 0, 0, 0);
    }
    LAS float* RED = (LAS float*)(lds + HG_RED);
    float ssq[16];
#pragma unroll
    for (int r = 0; r < 16; ++r) { float s = o[r] * o[r]; s += __shfl_xor(s, 1); s += __shfl_xor(s, 2); s += __shfl_xor(s, 4); s += __shfl_xor(s, 8); s += __shfl_xor(s, 16); ssq[r] = s; }
    if (r32 == 0) {
#pragma unroll
        for (int r = 0; r < 16; ++r) RED[jb * 64 + tb * 32 + crow(r, hi)] = ssq[r];
    }
    __syncthreads();
    {
        LAS float* STG = (LAS float*)lds;
        const int j = jb * 32 + r32; const float wj = rnw[j];
#pragma unroll
        for (int r = 0; r < 16; ++r) {
            const int t = tb * 32 + crow(r, hi);
            const float tot = RED[t] + RED[64 + t] + RED[128 + t] + RED[192 + t];
            const float rstd = 1.0f / sqrtf(tot * (1.f / 128.f) + EPS);
            STG[t * GST + j] = o[r] * rstd * wj;
        }
    }
    __syncthreads();
#pragma unroll
    for (int p = 0; p < 2; ++p) {
        const int r = r0 + 32 * p; float v8[8]; ld8((const LAS float*)lds + r * GST + c8, v8);
        const v4u gg = LL.g[p];
        const float g8[8] = {bflo(gg.x), bfhi(gg.x), bflo(gg.y), bfhi(gg.y), bflo(gg.z), bfhi(gg.z), bflo(gg.w), bfhi(gg.w)};
#pragma unroll
        for (int i = 0; i < 8; ++i) v8[i] *= g8[i] / (1.0f + __expf(-g8[i]));
        *(v4u*)(RQ + tile_off + (size_t)r * 1024 + c8) = (v4u){pk2(v8[0], v8[1]), pk2(v8[2], v8[3]), pk2(v8[4], v8[5]), pk2(v8[6], v8[7])};
    }
    __syncthreads();
}

__global__ void __launch_bounds__(NTHR, 2) fused_fwd(Args args) {
    extern __shared__ __attribute__((aligned(16))) unsigned char lds_raw[];
    cg::grid_group grid = cg::this_grid();
    LAS unsigned char* lds = (LAS unsigned char*)lds_raw;
    const int tid = threadIdx.x, lane = tid & 63, wave = __builtin_amdgcn_readfirstlane(tid >> 6);
    const int G = gridDim.x, bx = blockIdx.x;
    const int vcu = (G % 8 == 0) ? (bx % 8) * (G / 8) + bx / 8 : bx;
    const int gw = vcu * NWAVES + wave, NGW = G * NWAVES;
    unsigned char* ws = args.ws;
    const float* x = args.in[0]; const float* cvec = args.in[1];
    const float* w_ada = args.in[3]; const float* b_ada = args.in[4]; const float* norm_mix = args.in[5]; const float* w_in = args.in[6];
    const float* lam_q1 = args.in[7]; const float* lam_k1 = args.in[8]; const float* lam_q2 = args.in[9]; const float* lam_k2 = args.in[10];
    const float* subln_w = args.in[11]; const float* lb_logits = args.in[12]; const float* rec_norm_w = args.in[13];
    const float* w_pa = args.in[14]; const float* w_pr = args.in[15]; const float* w_out = args.in[16]; const float* norm_mlp = args.in[17];
    const float* w1 = args.in[18]; const float* w2 = args.in[19]; const float* norm_final = args.in[20];
    float* ada = (float*)(ws + WS_ADA); float* rope = (float*)(ws + WS_ROPE);
    bf16* Win_t = (bf16*)(ws + WS_WIN); bf16* Wpa_t = (bf16*)(ws + WS_WPA); bf16* Wpr_t = (bf16*)(ws + WS_WPR); bf16* Wout_t = (bf16*)(ws + WS_WOUT);
    bf16* W1_t = (bf16*)(ws + WS_W1); bf16* W2_t = (bf16*)(ws + WS_W2);
    bf16* XN = (bf16*)(ws + WS_XN); bf16* Y = (bf16*)(ws + WS_Y); bf16* P = (bf16*)(ws + WS_P); float* dec = (float*)(ws + WS_DEC);
    bf16* Pq = P, *Pk = P + PBUF, *Pv = P + 2 * PBUF, *Prq = P + 3 * PBUF, *Prf = P + 4 * PBUF, *Pri = P + 5 * PBUF, *Prg = P + 6 * PBUF, *Pga = P + 7 * PBUF, *Pgr = P + 8 * PBUF;
    float* Y1 = (float*)P;
    bf16* Oa = Pv;
    bf16* UH = P;
    unsigned char* dob = (unsigned char*)args.out;
    bf16* O0 = (bf16*)(dob + DO_O0); bf16* O1 = (bf16*)(dob + DO_O1); bf16* Ust = (bf16*)(dob + DO_UST);

    unsigned* barw = (unsigned*)(ws + WS_BAR);
    if (bx == 0) for (int i = tid; i < XCD_BAR_WORDS; i += NTHR) barw[i] = 0u;
    volatile LAS unsigned* bst = (volatile LAS unsigned*)(lds + 131072 + 512);
    if (tid < 2) bst[tid] = 0u;
    __syncthreads();
    if (bx < 96) {
        LAS float* scs = (LAS float*)lds;
        LAS float* part = (LAS float*)(lds + 16384);
        for (int i = tid; i < 4096; i += NTHR) { const float v = cvec[i]; scs[i] = v / (1.0f + __expf(-v)); }
        __syncthreads();
        const int n = bx * 64 + lane; float a0 = 0.f, a1 = 0.f, a2 = 0.f, a3 = 0.f;
        const float* wp = w_ada + (size_t)(wave * 128) * 6144 + n;
#pragma unroll 8
        for (int k = 0; k < 128; ++k) { const float wv = wp[(size_t)k * 6144]; const int kk = wave * 128 + k;
            a0 += scs[kk] * wv; a1 += scs[1024 + kk] * wv; a2 += scs[2048 + kk] * wv; a3 += scs[3072 + kk] * wv; }
        part[(wave * 4 + 0) * 64 + lane] = a0; part[(wave * 4 + 1) * 64 + lane] = a1; part[(wave * 4 + 2) * 64 + lane] = a2; part[(wave * 4 + 3) * 64 + lane] = a3;
        __syncthreads();
        if (wave < 4) { float s = b_ada[n];
#pragma unroll
            for (int w = 0; w < 8; ++w) s += part[(w * 4 + wave) * 64 + lane];
            ada[wave * 6144 + n] = s; }
        __syncthreads();
    }
    {
        LAS float* scr = (LAS float*)(lds + wave * 16384);
        constexpr int I_IN = 16 * (NIN / 32), I_SQ = 16 * 32, I_1 = 16 * (FF / 32), I_2 = (FF / 64) * 32;
        constexpr int NITEMS = I_IN + 3 * I_SQ + I_1 + I_2;
        for (int it = gw; it < NITEMS; it += NGW) {
            int r = it;
            if (r < I_IN) { p0_transpose_item(w_in, DM, NIN, Win_t, scr, r, lane); continue; } r -= I_IN;
            if (r < I_SQ) { p0_transpose_item(w_pa, DM, DM, Wpa_t, scr, r, lane); continue; } r -= I_SQ;
            if (r < I_SQ) { p0_transpose_item(w_pr, DM, DM, Wpr_t, scr, r, lane); continue; } r -= I_SQ;
            if (r < I_SQ) { p0_transpose_item(w_out, DM, DM, Wout_t, scr, r, lane); continue; } r -= I_SQ;
            if (r < I_1) { p0_transpose_item(w1, DM, FF, W1_t, scr, r, lane); continue; } r -= I_1;
            p0_transpose_item(w2, FF, DM, W2_t, scr, r, lane);
        }
        const float invf[8] = {1.0f, 0.1939227432012558f, 0.03760603070259094f, 0.007292664609849453f, 0.0014142135623842478f, 0.00027424818836152554f, 5.318296098266728e-05f, 1.0313386155758053e-05f};
        for (int row = bx * NTHR + tid; row < TT; row += G * NTHR) { const float pf = (float)args.pos[row];
#pragma unroll
            for (int i = 0; i < 8; ++i) { const float ang = pf * invf[i]; float sv, cv; sincosf(ang, &sv, &cv); rope[row * 16 + i] = cv; rope[row * 16 + 8 + i] = sv; } }
    }
    grid.sync();
    XcdBarrier xbar = xcd_barrier_post(barw, bst);
    { const int t1 = fresh_tid(), lane = t1 & 63, gw = vcu * NWAVES + (t1 >> 6);
    for (int m = gw; m < TT; m += NGW) { const int b = m >> 13;
        norm_mod_row(x + (size_t)m * DM, norm_mix, ada + b * 6144 + 1024, ada + b * 6144, XN + (size_t)m * DM, lane); } }
    xcd_barrier(xbar);

    for (int half = 0; half < 2; ++half) {
        { pg8::Gemm g{XN + (size_t)half * TH * DM, Win_t, TH, NIN, DM}; pg8::StaticOrder S; S.init(TH, NIN, G, bx);
          pg8::EpiInProj E{P, rope + (size_t)half * TH * 16};
          pg8::gemm_phase<pg8::EpiInProj, pg8::StaticOrder, true, true>(lds, g, S, E); }
        xcd_barrier(xbar);
        for (int cb = vcu; cb < 512; cb += G) {
            const int s = cb & 7, vb = cb >> 3;
            for (int i = 0; i < 4; ++i) {
                const int qb = (i == 0) ? s : (i == 1) ? 15 - s : (i == 2) ? 16 + s : 31 - s;
                const int b = vb >> 5, h = (vb >> 2) & 7, m = (vb >> 1) & 1, e = vb & 1;
                attn_body::attn_unit<8>(b, h * 2 + m, h * 2 + e, qb, (const attn_body::bf16*)Pq, (const attn_body::bf16*)Pk, (const attn_body::bf16*)Pv,
                                        (attn_body::bf16*)(m ? O1 : O0), (char*)lds_raw);
            }
        }
        { const int t3 = fresh_tid();
          for (int u = vcu; u < 2048; u += G) { HgIn1 cur; hg_load1(cur, Prf, Pri, u, t3); hg_unit_state(lds, cur, lb_logits, Ust, dec, u, t3); } }
        xcd_barrier(xbar);
        for (int gid = vcu * NTHR + fresh_tid(); gid < 131072; gid += G * NTHR) {
            const int bh = gid >> 13, e2 = gid & 8191, k0 = (2 * e2) & 127;
            unsigned* up = (unsigned*)(Ust + (size_t)bh * 128 * 16384 + 2 * e2);
            const float* dp = dec + (size_t)bh * 128 * 128 + k0;
            float s0 = 0.f, s1 = 0.f;
            for (int c0 = 0; c0 < 128; c0 += 16) {
                unsigned uu[16]; float d0[16], d1[16];
#pragma unroll
                for (int i = 0; i < 16; ++i) { uu[i] = up[(size_t)(c0 + i) * 8192]; const float2 dd = *(const float2*)(dp + (c0 + i) * 128); d0[i] = dd.x; d1[i] = dd.y; }
#pragma unroll
                for (int i = 0; i < 16; ++i) { up[(size_t)(c0 + i) * 8192] = pk2(s0, s1); s0 = d0[i] * s0 + bflo(uu[i]); s1 = d1[i] * s1 + bfhi(uu[i]); }
            }
        }
        xcd_barrier(xbar);
        { const int t5 = fresh_tid();
          for (int u = vcu; u < 2048; u += G) { HgIn3 cur; hg_load3(cur, Prq, Prf, Pri, Prg, Ust, u, t5); hg_unit_out(lds, Prq, cur, Prg, Ust, lb_logits, rec_norm_w, u, t5); } }
        { const int t5c = fresh_tid(), lane = t5c & 63, gw = vcu * NWAVES + (t5c >> 6);
          float lam; { const float d1 = wave_sum(lam_q1[lane] * lam_k1[lane]), d2 = wave_sum(lam_q2[lane] * lam_k2[lane]); lam = __expf(d1) - __expf(d2) + 0.2f; }
        for (int m = gw; m < TH; m += NGW) {
            const v4u* a = (const v4u*)(O0 + (size_t)m * DM) + lane * 2; const v4u* b = (const v4u*)(O1 + (size_t)m * DM) + lane * 2;
            const v4u a0 = a[0], a1 = a[1], b0 = b[0], b1 = b[1];
            const unsigned aw[8] = {a0.x, a0.y, a0.z, a0.w, a1.x, a1.y, a1.z, a1.w}, bw[8] = {b0.x, b0.y, b0.z, b0.w, b1.x, b1.y, b1.z, b1.w};
            float o[16]; float ss = 0.f;
#pragma unroll
            for (int i = 0; i < 8; ++i) { o[2 * i] = bflo(aw[i]) - lam * bflo(bw[i]); o[2 * i + 1] = bfhi(aw[i]) - lam * bfhi(bw[i]); ss += o[2 * i] * o[2 * i] + o[2 * i + 1] * o[2 * i + 1]; }
            ss += __shfl_xor(ss, 1); ss += __shfl_xor(ss, 2); ss += __shfl_xor(ss, 4);
            const float rstd = 0.8f / sqrtf(ss * (1.f / 128.f) + EPS);
            const float* wp = subln_w + (lane & 7) * 16;
            unsigned ow[8];
#pragma unroll
            for (int i = 0; i < 8; ++i) ow[i] = pk2(o[2 * i] * rstd * wp[2 * i], o[2 * i + 1] * rstd * wp[2 * i + 1]);
            v4u* op = (v4u*)(Oa + (size_t)m * DM) + lane * 2;
            op[0] = (v4u){ow[0], ow[1], ow[2], ow[3]}; op[1] = (v4u){ow[4], ow[5], ow[6], ow[7]};
        } }
        xcd_barrier(xbar);
        { pg8::Gemm g{Oa, Wpa_t, TH, DM, DM}; pg8::StaticOrder S; S.init(TH, DM, G, bx);
          pg8::EpiGate1 E{Pga, Y1};
          pg8::gemm_phase<pg8::EpiGate1, pg8::StaticOrder, true, true>(lds, g, S, E); }
        { pg8::Gemm g{Prq, Wpr_t, TH, DM, DM}; pg8::StaticOrder S; S.init(TH, DM, G, bx);
          pg8::EpiGate2 E{Pgr, Y1, Y + (size_t)half * TH * DM};
          pg8::gemm_phase<pg8::EpiGate2, pg8::StaticOrder, true, true>(lds, g, S, E); }
        xcd_barrier(xbar);
    }
    { pg8::Gemm g{Y, Wout_t, TT, DM, DM}; pg8::StaticOrder S; S.init(TT, DM, G, bx);
      pg8::EpiRes E{x, args.out, ada + 2048};
      pg8::gemm_phase<pg8::EpiRes, pg8::StaticOrder, true, true>(lds, g, S, E); }
    xcd_barrier(xbar);
    { const int t8 = fresh_tid(), lane = t8 & 63, gw = vcu * NWAVES + (t8 >> 6);
    for (int m = gw; m < TT; m += NGW) { const int b = m >> 13;
        norm_mod_row(args.out + (size_t)m * DM, norm_mlp, ada + b * 6144 + 4096, ada + b * 6144 + 3072, XN + (size_t)m * DM, lane); } }
    xcd_barrier(xbar);
    { pg8::Gemm g{XN, W1_t, TT, FF, DM}; pg8::StaticOrder S; S.init(TT, FF, G, bx);
      pg8::EpiRelu2 E{UH, FF};
      pg8::gemm_phase<pg8::EpiRelu2, pg8::StaticOrder, true, true>(lds, g, S, E); }
    xcd_barrier(xbar);
    { pg8::Gemm g{UH, W2_t, TT, DM, FF}; pg8::StaticOrder S; S.init(TT, DM, G, bx);
      pg8::EpiRes E{args.out, args.out, ada + 5120};
      pg8::gemm_phase<pg8::EpiRes, pg8::StaticOrder, true, true>(lds, g, S, E); }
    xcd_barrier(xbar);
    { const int t11 = fresh_tid(), lane = t11 & 63, gw = vcu * NWAVES + (t11 >> 6);
    for (int m = gw; m < TT; m += NGW) {
        f32x4* xr = (f32x4*)(args.out + (size_t)m * DM) + lane;
        f32x4 v[4]; float s = 0.f;
#pragma unroll
        for (int j = 0; j < 4; ++j) { v[j] = xr[64 * j]; s += (v[j].x * v[j].x + v[j].y * v[j].y) + (v[j].z * v[j].z + v[j].w * v[j].w); }
        const float rinv = 1.0f / sqrtf(wave_sum(s) * (1.f / 1024.f) + EPS);
#pragma unroll
        for (int j = 0; j < 4; ++j) xr[64 * j] = v[j] * rinv * ((const f32x4*)norm_final)[lane + 64 * j];
    } }
}

extern "C" void kernel_launch(void* const* d_in, const int* in_sizes, int n_in, void* d_out, int out_size, void* d_ws, size_t ws_size, hipStream_t stream) {
    static int grid = 0;
    if (grid == 0) {
        if (n_in != 21 || in_sizes[0] != TT * DM || out_size != TT * DM || ws_size < WS_END) {
            fprintf(stderr, "kernel_launch: unexpected shapes: n_in %d in0 %d out %d ws %zu (need %zu)\n", n_in, n_in > 0 ? in_sizes[0] : -1, out_size, ws_size, (size_t)WS_END); grid = -1; return; }
        int dev = 0, cus = 0, per_cu = 0;
        hipGetDevice(&dev); hipDeviceGetAttribute(&cus, hipDeviceAttributeMultiprocessorCount, dev);
        if (hipFuncSetAttribute((const void*)fused_fwd, hipFuncAttributeMaxDynamicSharedMemorySize, LDS_BYTES) != hipSuccess) { fprintf(stderr, "kernel_launch: hipFuncSetAttribute failed\n"); grid = -1; return; }
        if (hipOccupancyMaxActiveBlocksPerMultiprocessor(&per_cu, (const void*)fused_fwd, NTHR, LDS_BYTES) != hipSuccess || per_cu < 1) { fprintf(stderr, "kernel_launch: occupancy query says %d\n", per_cu); per_cu = 1; }
        (void)hipGetLastError();
        grid = cus * 1;
        (void)per_cu;
    }
    if (grid < 0) return;
    Args a{};
    for (int i = 0; i < 21; ++i) a.in[i] = (const float*)d_in[i];
    a.pos = (const int*)d_in[2]; a.out = (float*)d_out; a.ws = (unsigned char*)d_ws;
    void* kargs[] = {&a};
    hipError_t e = hipLaunchCooperativeKernel((const void*)fused_fwd, dim3(grid), dim3(NTHR), kargs, LDS_BYTES, stream);
    if (e != hipSuccess) fprintf(stderr, "cooperative launch failed: %s (grid %d)\n", hipGetErrorString(e), grid);
}
```

```cpp
#include <hip/hip_runtime.h>
#include <hip/hip_cooperative_groups.h>
#include <cstdio>
#include <cstdint>
namespace cg = cooperative_groups;
__device__ __forceinline__ int fresh_tid() { int t = threadIdx.x; asm volatile("" : "+v"(t)); return t; }
namespace pg8 {
#define PG8_LAS __attribute__((address_space(3)))
typedef unsigned short bf16_t;
typedef short bf16x8 __attribute__((ext_vector_type(8)));
typedef float f32x4 __attribute__((ext_vector_type(4)));
typedef unsigned u32x4 __attribute__((ext_vector_type(4)));
constexpr int BM = 256, BK = 64, HALF = 128, HTB = HALF * BK * 2  , STAGE_BYTES = 8 * HTB, NXCD = 8, WGM = 8;

__host__ __device__ __forceinline__ int lds_byte(int r, int c) { const int st = (r >> 4) * 2 + (c >> 5), rr = r & 15, cc = c & 31, ob = rr * 64 + cc * 2; return st * 1024 + (ob ^ (((ob >> 9) & 1) << 5)); }
__host__ __device__ __forceinline__ void stage_rc(int b, int& R, int& C) { const int st = b / 1024, sb = b % 1024, swz = sb ^ (((sb >> 9) & 1) << 5); R = (st >> 1) * 16 + swz / 64; C = (st & 1) * 32 + (swz % 64) / 2; }
__host__ __device__ __forceinline__ int perm32(int rho) { const int n = rho >> 4, i = rho & 15; return 8 * (i >> 2) + 4 * n + (i & 3); }

struct Unit { int pm, pn; };
struct Gemm { const bf16_t* A; const bf16_t* Bt; int M, N, K; };

struct StaticOrder {
    int nM, nN, nwg, G, c;
    __host__ __device__ void init(int M, int N, int G_, int c_) { nM = M / BM; nN = N / BM; nwg = nM * nN; G = G_; c = c_; }
    __host__ __device__ bool next(int i, Unit& u) const {
        const long L = (long)i * G + c; if (L >= nwg) return false;
        int wgid = (int)L; { const int q = nwg / NXCD, r = nwg % NXCD, xcd = wgid % NXCD, off = wgid / NXCD; wgid = (xcd < r ? xcd * (q + 1) : r * (q + 1) + (xcd - r) * q) + off; }
        const int nig = WGM * nN, gid = wgid / nig, fm = gid * WGM, gsz = (nM - fm) < WGM ? (nM - fm) : WGM;
        u.pm = fm + ((wgid % nig) % gsz); u.pn = (wgid % nig) / gsz; return true;
    }
    __device__ __forceinline__ void a_ready(const Unit&) const {}
    __device__ __forceinline__ void done(const Unit&) const {}
};

__device__ __forceinline__ unsigned cvt_pk_bf16(float lo, float hi) { unsigned r; asm volatile("v_cvt_pk_bf16_f32 %0, %1, %2" : "=v"(r) : "v"(lo), "v"(hi)); return r; }
__device__ __forceinline__ float bf_lo(unsigned w) { return __uint_as_float(w << 16); }
__device__ __forceinline__ float bf_hi(unsigned w) { return __uint_as_float(w & 0xffff0000u); }
__device__ __forceinline__ float sigmoidf_(float x) { return __builtin_amdgcn_rcpf(1.0f + __expf(-x)); }
constexpr int TH_ROWS = 16384;
constexpr float QSCALE = 0.125f * 1.4426950408889634f;

struct EpiInProj {
    static constexpr bool PERM = true, AFTER_DRAIN = false;
    bf16_t* P; const float* rope;
    __device__ __forceinline__ void operator()(const f32x4 (&acc)[2][2][4][2], const Unit& u, int wr, int wc, int fr, int fq) const {
        const int t = u.pn >> 2, colt = (u.pn & 3) * 256;
        bf16_t* base = P + (size_t)t * TH_ROWS * 1024;
        const int row0 = u.pm * BM + wr * 64 + fr, col0 = colt + wc * 32 + 8 * fq;
        const bool isrope = (t < 2) && ((wc & 1) == 0);
        const float sc = (t == 0) ? QSCALE : 1.f;
        const float sgn = (fq == 0) ? -1.f : ((fq == 1) ? 1.f : 0.f);
#pragma unroll
        for (int ai = 0; ai < 2; ++ai)
#pragma unroll
            for (int m = 0; m < 4; ++m) {
                const int row = row0 + ai * HALF + m * 16;
                f32x4 c0 = {1.f, 1.f, 1.f, 1.f}, c1 = c0, s0 = {0.f, 0.f, 0.f, 0.f}, s1 = s0;
                if (isrope) { const f32x4* rp = (const f32x4*)(rope + (size_t)row * 16); f32x4 a = rp[0], b = rp[1], c = rp[2], d = rp[3];
                    if (fq < 2) { c0 = a; c1 = b; } s0 = c * sgn; s1 = d * sgn; }
                bf16_t* rowp = base + (size_t)row * 1024 + col0;
#pragma unroll
                for (int bj = 0; bj < 2; ++bj) {
                    f32x4 v0 = acc[ai][bj][m][0], v1 = acc[ai][bj][m][1];
                    if (isrope) {
                        f32x4 p0, p1;
#pragma unroll
                        for (int j = 0; j < 4; ++j) { p0[j] = __shfl_xor(v0[j], 16); p1[j] = __shfl_xor(v1[j], 16); }
                        v0 = v0 * c0 + p0 * s0; v1 = v1 * c1 + p1 * s1;
                    }
                    v0 = v0 * sc; v1 = v1 * sc;
                    u32x4 w; w.x = cvt_pk_bf16(v0[0], v0[1]); w.y = cvt_pk_bf16(v0[2], v0[3]); w.z = cvt_pk_bf16(v1[0], v1[1]); w.w = cvt_pk_bf16(v1[2], v1[3]);
                    *(u32x4*)(rowp + bj * HALF) = w;
                }
            }
    }
};
struct EpiGate1 {
    static constexpr bool PERM = true, AFTER_DRAIN = false;
    const bf16_t* gate; float* Y1;
    __device__ __forceinline__ void operator()(const f32x4 (&acc)[2][2][4][2], const Unit& u, int wr, int wc, int fr, int fq) const {
        const int row0 = u.pm * BM + wr * 64 + fr, col0 = u.pn * BM + wc * 32 + 8 * fq;
#pragma unroll
        for (int ai = 0; ai < 2; ++ai)
#pragma unroll
            for (int m = 0; m < 4; ++m) {
                const size_t off = (size_t)(row0 + ai * HALF + m * 16) * 1024 + col0;
#pragma unroll
                for (int bj = 0; bj < 2; ++bj) {
                    const u32x4 g = *(const u32x4*)(gate + off + bj * HALF);
                    f32x4 v0 = acc[ai][bj][m][0], v1 = acc[ai][bj][m][1];
                    v0[0] *= sigmoidf_(bf_lo(g.x)); v0[1] *= sigmoidf_(bf_hi(g.x)); v0[2] *= sigmoidf_(bf_lo(g.y)); v0[3] *= sigmoidf_(bf_hi(g.y));
                    v1[0] *= sigmoidf_(bf_lo(g.z)); v1[1] *= sigmoidf_(bf_hi(g.z)); v1[2] *= sigmoidf_(bf_lo(g.w)); v1[3] *= sigmoidf_(bf_hi(g.w));
                    *(f32x4*)(Y1 + off + bj * HALF) = v0; *(f32x4*)(Y1 + off + bj * HALF + 4) = v1;
                }
            }
    }
};
struct EpiGate2 {
    static constexpr bool PERM = true, AFTER_DRAIN = false;
    const bf16_t* gate; const float* Y1; bf16_t* Y;
    __device__ __forceinline__ void operator()(const f32x4 (&acc)[2][2][4][2], const Unit& u, int wr, int wc, int fr, int fq) const {
        const int row0 = u.pm * BM + wr * 64 + fr, col0 = u.pn * BM + wc * 32 + 8 * fq;
#pragma unroll
        for (int ai = 0; ai < 2; ++ai)
#pragma unroll
            for (int m = 0; m < 4; ++m) {
                const size_t off = (size_t)(row0 + ai * HALF + m * 16) * 1024 + col0;
#pragma unroll
                for (int bj = 0; bj < 2; ++bj) {
                    const u32x4 g = *(const u32x4*)(gate + off + bj * HALF);
                    const f32x4 y0 = *(const f32x4*)(Y1 + off + bj * HALF), y1 = *(const f32x4*)(Y1 + off + bj * HALF + 4);
                    f32x4 v0 = acc[ai][bj][m][0], v1 = acc[ai][bj][m][1];
                    v0[0] = y0[0] + v0[0] * sigmoidf_(bf_lo(g.x)); v0[1] = y0[1] + v0[1] * sigmoidf_(bf_hi(g.x)); v0[2] = y0[2] + v0[2] * sigmoidf_(bf_lo(g.y)); v0[3] = y0[3] + v0[3] * sigmoidf_(bf_hi(g.y));
                    v1[0] = y1[0] + v1[0] * sigmoidf_(bf_lo(g.z)); v1[1] = y1[1] + v1[1] * sigmoidf_(bf_hi(g.z)); v1[2] = y1[2] + v1[2] * sigmoidf_(bf_lo(g.w)); v1[3] = y1[3] + v1[3] * sigmoidf_(bf_hi(g.w));
                    u32x4 w; w.x = cvt_pk_bf16(v0[0], v0[1]); w.y = cvt_pk_bf16(v0[2], v0[3]); w.z = cvt_pk_bf16(v1[0], v1[1]); w.w = cvt_pk_bf16(v1[2], v1[3]);
                    *(u32x4*)(Y + off + bj * HALF) = w;
                }
            }
    }
};
struct EpiRes {
    static constexpr bool PERM = false, AFTER_DRAIN = false;
    const float* base; float* out; const float* gate;
    __device__ __forceinline__ void operator()(const f32x4 (&acc)[2][2][4][2], const Unit& u, int wr, int wc, int fr, int fq) const {
        const int row0 = u.pm * BM + wr * 64 + fr, col0 = u.pn * BM + wc * 32 + 4 * fq;
        const float* gp = gate + (size_t)((u.pm * BM) >> 13) * 6144 + col0;
        f32x4 gv[2][2];
#pragma unroll
        for (int bj = 0; bj < 2; ++bj)
#pragma unroll
            for (int n = 0; n < 2; ++n) gv[bj][n] = *(const f32x4*)(gp + bj * HALF + n * 16);
#pragma unroll
        for (int ai = 0; ai < 2; ++ai)
#pragma unroll
            for (int m = 0; m < 4; ++m) {
                const size_t off = (size_t)(row0 + ai * HALF + m * 16) * 1024 + col0;
#pragma unroll
                for (int bj = 0; bj < 2; ++bj)
#pragma unroll
                    for (int n = 0; n < 2; ++n) { const f32x4 bs = *(const f32x4*)(base + off + bj * HALF + n * 16);
                        *(f32x4*)(out + off + bj * HALF + n * 16) = bs + gv[bj][n] * acc[ai][bj][m][n]; }
            }
    }
};
struct EpiRelu2 {
    static constexpr bool PERM = true, AFTER_DRAIN = false;
    bf16_t* O; int ldc;
    __device__ __forceinline__ void operator()(const f32x4 (&acc)[2][2][4][2], const Unit& u, int wr, int wc, int fr, int fq) const {
        const int row0 = u.pm * BM + wr * 64 + fr, col0 = u.pn * BM + wc * 32 + 8 * fq;
#pragma unroll
        for (int ai = 0; ai < 2; ++ai)
#pragma unroll
            for (int m = 0; m < 4; ++m) {
                bf16_t* rowp = O + (size_t)(row0 + ai * HALF + m * 16) * ldc + col0;
#pragma unroll
                for (int bj = 0; bj < 2; ++bj) {
                    f32x4 v0 = acc[ai][bj][m][0], v1 = acc[ai][bj][m][1];
#pragma unroll
                    for (int j = 0; j < 4; ++j) { const float a = fmaxf(v0[j], 0.f), b = fmaxf(v1[j], 0.f); v0[j] = a * a; v1[j] = b * b; }
                    u32x4 w; w.x = cvt_pk_bf16(v0[0], v0[1]); w.y = cvt_pk_bf16(v0[2], v0[3]); w.z = cvt_pk_bf16(v1[0], v1[1]); w.w = cvt_pk_bf16(v1[2], v1[3]);
                    *(u32x4*)(rowp + bj * HALF) = w;
                }
            }
    }
};
template <class Epi, class Sched, bool ALIGN_EPI = false, bool SP2 = false>
__device__ __forceinline__ void gemm_phase(PG8_LAS unsigned char* lds, const Gemm g, const Sched& S, const Epi& E) {
    const int tid = fresh_tid(), wid = __builtin_amdgcn_readfirstlane(tid >> 6), lane = tid & 63, wr = wid >> 2, wc = wid & 3, fr = lane & 15, fq = lane >> 4;
    const int K = g.K, nt = K / BK;
    unsigned voffA[2], voffB[2];
#pragma unroll
    for (int i = 0; i < 2; ++i) { int R, C; stage_rc(tid * 16 + i * 8192, R, C); const int Rb = Epi::PERM ? ((R & ~31) + perm32(R & 31)) : R;
        voffA[i] = (unsigned)(R * K + C) * 2u; voffB[i] = (unsigned)(Rb * K + C) * 2u; }
    const size_t kstep = (size_t)(BK * 2);
    const size_t hstep = (size_t)HALF * K * 2;
    const size_t tstep = 2 * hstep;
    const unsigned ldsw = (unsigned)wid * 1024u;
    const int aoff = lds_byte(wr * 64 + fr, fq * 8), boff = lds_byte(wc * 32 + fr, fq * 8);
#define PG8_SA(b, h) (((b) * 2 + (h)) * HTB)
#define PG8_SB(b, h) ((4 + (b) * 2 + (h)) * HTB)
#define PG8_STAGE(bufoff, gbase, voff) do { _Pragma("unroll") for (int _i = 0; _i < 2; ++_i) \
        __builtin_amdgcn_global_load_lds((const unsigned*)((const char*)(gbase) + (voff)[_i]), (PG8_LAS unsigned*)(lds + (bufoff) + ldsw + _i * 8192), 16, 0, 0); } while (0)
#define PG8_LDA(dst, b, h) do { _Pragma("unroll") for (int m = 0; m < 4; ++m) _Pragma("unroll") for (int k = 0; k < 2; ++k) dst[m][k] = *(const PG8_LAS bf16x8*)(lds + PG8_SA(b, h) + aoff + m * 2048 + k * 1024); } while (0)
#define PG8_LDB(dst, b, h) do { _Pragma("unroll") for (int n = 0; n < 2; ++n) _Pragma("unroll") for (int k = 0; k < 2; ++k) dst[n][k] = *(const PG8_LAS bf16x8*)(lds + PG8_SB(b, h) + boff + n * 2048 + k * 1024); } while (0)
#define PG8_MMA(ai, bj, At, Bt) do { __builtin_amdgcn_s_setprio(1); _Pragma("unroll") for (int m = 0; m < 4; ++m) _Pragma("unroll") for (int n = 0; n < 2; ++n) _Pragma("unroll") for (int k = 0; k < 2; ++k) \
        acc[ai][bj][m][n] = __builtin_amdgcn_mfma_f32_16x16x32_bf16(Bt[n][k], At[m][k], acc[ai][bj][m][n], 0, 0, 0); __builtin_amdgcn_s_setprio(0); } while (0)
#define PG8_WAIT_V(n) asm volatile("s_waitcnt vmcnt(" #n ")" ::: "memory")
#define PG8_WAIT_L(n) asm volatile("s_waitcnt lgkmcnt(" #n ")" ::: "memory")
#define PG8_BAR __builtin_amdgcn_s_barrier()
#define PG8_SCHED __builtin_amdgcn_sched_barrier(0)
    Unit cur, nxt; int ui = 0;
    if (!S.next(0, cur)) return;
    f32x4 acc[2][2][4][2];
#pragma unroll
    for (int a = 0; a < 2; ++a)
#pragma unroll
        for (int b = 0; b < 2; ++b)
#pragma unroll
            for (int m = 0; m < 4; ++m)
#pragma unroll
                for (int n = 0; n < 2; ++n) acc[a][b][m][n] = (f32x4){0.f, 0.f, 0.f, 0.f};
    bf16x8 At[4][2], B0[2][2], B1[2][2];
    const char* cA = (const char*)g.A + (size_t)cur.pm * tstep; const char* cB = (const char*)g.Bt + (size_t)cur.pn * tstep;
    S.a_ready(cur);
    if constexpr (SP2) {
        PG8_STAGE(PG8_SB(0, 0), cB, voffB); PG8_STAGE(PG8_SB(0, 1), cB + hstep, voffB); PG8_STAGE(PG8_SA(0, 0), cA, voffA); PG8_STAGE(PG8_SA(0, 1), cA + hstep, voffA);
        if (wr == 1) PG8_BAR;
        PG8_WAIT_V(2); PG8_BAR;
        PG8_STAGE(PG8_SB(1, 0), cB + kstep, voffB); PG8_STAGE(PG8_SA(1, 0), cA + kstep, voffA); PG8_STAGE(PG8_SB(1, 1), cB + hstep + kstep, voffB);
        PG8_WAIT_V(6); PG8_BAR;
    } else {
        PG8_STAGE(PG8_SB(0, 0), cB, voffB); PG8_STAGE(PG8_SA(0, 0), cA, voffA); PG8_STAGE(PG8_SB(0, 1), cB + hstep, voffB); PG8_STAGE(PG8_SA(0, 1), cA + hstep, voffA);
        if (wr == 1) PG8_BAR;
        PG8_WAIT_V(4); PG8_BAR;
        PG8_STAGE(PG8_SB(1, 0), cB + kstep, voffB); PG8_STAGE(PG8_SA(1, 0), cA + kstep, voffA); PG8_STAGE(PG8_SB(1, 1), cB + hstep + kstep, voffB);
        PG8_WAIT_V(6); PG8_BAR;
    }
    for (;;) {
        const bool has_next = S.next(ui + 1, nxt);
        const char* nA = has_next ? (const char*)g.A + (size_t)nxt.pm * tstep : cA; const char* nB = has_next ? (const char*)g.Bt + (size_t)nxt.pn * tstep : cB;
        for (int t = 0; t < nt; t += 2) {
            const bool last = (t == nt - 2);
            const char* a1 = cA + (size_t)(t + 1) * kstep;
            const char* a2 = last ? nA : cA + (size_t)(t + 2) * kstep; const char* b2 = last ? nB : cB + (size_t)(t + 2) * kstep;
            const char* a3 = a2 + kstep; const char* b3 = b2 + kstep;
            if (last && has_next) S.a_ready(nxt);
            if constexpr (SP2) {
            PG8_LDB(B0, 0, 0); PG8_LDB(B1, 0, 1); PG8_SCHED; PG8_LDA(At, 0, 0); PG8_STAGE(PG8_SA(1, 1), a1 + hstep, voffA);
            PG8_WAIT_V(8); PG8_WAIT_L(0); PG8_BAR; PG8_MMA(0, 0, At, B0); PG8_MMA(0, 1, At, B1); PG8_BAR; PG8_SCHED;
            PG8_LDA(At, 0, 1); PG8_STAGE(PG8_SB(0, 0), b2, voffB); PG8_STAGE(PG8_SB(0, 1), b2 + hstep, voffB); PG8_STAGE(PG8_SA(0, 0), a2, voffA);
            PG8_WAIT_V(8); PG8_WAIT_L(0); PG8_BAR; PG8_MMA(1, 0, At, B0); PG8_MMA(1, 1, At, B1); PG8_BAR; PG8_SCHED;
            PG8_LDB(B0, 1, 0); PG8_LDB(B1, 1, 1); PG8_SCHED; PG8_LDA(At, 1, 0); PG8_STAGE(PG8_SA(0, 1), a2 + hstep, voffA);
            PG8_WAIT_V(8); PG8_WAIT_L(0); PG8_BAR; PG8_MMA(0, 0, At, B0); PG8_MMA(0, 1, At, B1); PG8_BAR; PG8_SCHED;
            PG8_LDA(At, 1, 1); PG8_STAGE(PG8_SB(1, 0), b3, voffB); PG8_STAGE(PG8_SB(1, 1), b3 + hstep, voffB); PG8_STAGE(PG8_SA(1, 0), a3, voffA);
            PG8_WAIT_V(8); PG8_WAIT_L(0); PG8_BAR; PG8_MMA(1, 0, At, B0); PG8_MMA(1, 1, At, B1); PG8_BAR; PG8_SCHED;
            } else {
            PG8_LDB(B0, 0, 0); PG8_SCHED; PG8_LDA(At, 0, 0); PG8_STAGE(PG8_SA(1, 1), a1 + hstep, voffA);
            PG8_WAIT_L(8); PG8_BAR; PG8_WAIT_L(0); PG8_MMA(0, 0, At, B0); PG8_BAR; PG8_SCHED;
            PG8_LDB(B1, 0, 1); PG8_STAGE(PG8_SB(0, 0), b2, voffB);
            PG8_BAR; PG8_WAIT_L(0); PG8_MMA(0, 1, At, B1); PG8_BAR;
            PG8_LDA(At, 0, 1); PG8_STAGE(PG8_SA(0, 0), a2, voffA);
            PG8_BAR; PG8_WAIT_L(0); PG8_MMA(1, 0, At, B0); PG8_BAR; PG8_SCHED;
            PG8_STAGE(PG8_SB(0, 1), b2 + hstep, voffB);
            PG8_WAIT_V(6); PG8_BAR; PG8_MMA(1, 1, At, B1); PG8_BAR;
            PG8_LDB(B0, 1, 0); PG8_SCHED; PG8_LDA(At, 1, 0); PG8_STAGE(PG8_SA(0, 1), a2 + hstep, voffA);
            PG8_WAIT_L(8); PG8_BAR; PG8_WAIT_L(0); PG8_MMA(0, 0, At, B0); PG8_BAR; PG8_SCHED;
            PG8_LDB(B1, 1, 1); PG8_STAGE(PG8_SB(1, 0), b3, voffB);
            PG8_BAR; PG8_WAIT_L(0); PG8_MMA(0, 1, At, B1); PG8_BAR;
            PG8_LDA(At, 1, 1); PG8_STAGE(PG8_SA(1, 0), a3, voffA);
            PG8_BAR; PG8_WAIT_L(0); PG8_MMA(1, 0, At, B0); PG8_BAR; PG8_SCHED;
            PG8_STAGE(PG8_SB(1, 1), b3 + hstep, voffB);
            PG8_WAIT_V(6); PG8_BAR; PG8_MMA(1, 1, At, B1); PG8_BAR;
            }
        }
        if constexpr (ALIGN_EPI) { if (wr == 0) PG8_BAR; }
        if constexpr (!Epi::AFTER_DRAIN) { E(acc, cur, wr, wc, fr, fq); S.done(cur); }
        if (!has_next) break;
#pragma unroll
        for (int a = 0; a < 2; ++a)
#pragma unroll
            for (int b = 0; b < 2; ++b)
#pragma unroll
                for (int m = 0; m < 4; ++m)
#pragma unroll
                    for (int n = 0; n < 2; ++n) acc[a][b][m][n] = (f32x4){0.f, 0.f, 0.f, 0.f};
        cur = nxt; cA = nA; cB = nB; ++ui;
        if constexpr (ALIGN_EPI) { if (wr == 1) PG8_BAR; }
    }
    PG8_WAIT_V(0);
    if constexpr (!ALIGN_EPI) { if (wr == 0) PG8_BAR; }
    PG8_BAR;
    if constexpr (Epi::AFTER_DRAIN) { E.fused(acc, cur, wr, wc, fr, fq, lds, wid, lane); S.done(cur); }
#undef PG8_SA
#undef PG8_SB
#undef PG8_STAGE
#undef PG8_LDA
#undef PG8_LDB
#undef PG8_MMA
#undef PG8_WAIT_V
#undef PG8_WAIT_L
#undef PG8_BAR
#undef PG8_SCHED
}
}
#include <hip/hip_bf16.h>
#include <cmath>
namespace attn_body {
using bf16=__hip_bfloat16;
using bf16x8=__attribute__((ext_vector_type(8)))short;
using s16x4=__attribute__((ext_vector_type(4)))short;
using f32x16=__attribute__((ext_vector_type(16)))float;
using u32x4=__attribute__((ext_vector_type(4)))unsigned;
constexpr int BATCH=2,NHEAD=16,SEQ=8192,D=64,DM=NHEAD*D;
constexpr int NW=8,QBLK=32,QB=QBLK*NW,KVBLK=64,NQB=SEQ/QB;
constexpr int ATTN_PITCH=DM, ATTN_UNIT_ROWS=QB;
__device__ __forceinline__ int crow(int r,int hi){return (r&3)+8*(r>>2)+4*hi;}
#define SBAR() __builtin_amdgcn_sched_barrier(0)
__device__ __forceinline__ void cmask(f32x16&p0,f32x16&p1,int jb,int qrel,int hi){
  const float NEG=-INFINITY; int kb=64*jb+4*hi;
  #pragma unroll
  for(int r=0;r<16;++r){int kv=kb+(r&3)+8*(r>>2); if(kv>qrel)p0[r]=NEG; if(kv+32>qrel)p1[r]=NEG;}
}

constexpr int NSLOT=3, SLOTB=8192;
constexpr int LDS_K=0, LDS_V=NSLOT*SLOTB, LDS_WS=3*NSLOT*SLOTB, LDS_OST=LDS_WS+NW*64*4, LDS_BYTES=LDS_OST+NW*4096;
constexpr float C2=0.125f*1.4426950408889634f;
__device__ __forceinline__ void glds16(const void*gsrc,unsigned lds_dst){unsigned keep;
  asm volatile("s_mov_b32 %0, m0\n\ts_mov_b32 m0, %2\n\ts_nop 0\n\tglobal_load_lds_dwordx4 %1, off\n\ts_mov_b32 m0, %0":"=&s"(keep):"v"(gsrc),"s"(lds_dst):"memory");}
__device__ __forceinline__ float max3f(float a,float b,float c){float r;asm("v_max3_f32 %0, %1, %2, %3":"=v"(r):"v"(a),"v"(b),"v"(c));return r;}
__device__ __forceinline__ float max2f(float a,float b){float r;asm("v_max_f32_e32 %0, %1, %2":"=v"(r):"v"(a),"v"(b));return r;}
__device__ __forceinline__ float fadd_s(float a,float b){float r;asm("v_add_f32_e32 %0, %1, %2":"=v"(r):"v"(a),"v"(b));return r;}
__device__ __forceinline__ float fsub_s(float a,float b){float r;asm("v_sub_f32_e32 %0, %1, %2":"=v"(r):"v"(a),"v"(b));return r;}
typedef float f32x2_t __attribute__((ext_vector_type(2))); typedef __bf16 bf16x2_t __attribute__((ext_vector_type(2)));
__device__ __forceinline__ unsigned cvtpk_s(float lo,float hi){f32x2_t v={lo,hi};bf16x2_t b=__builtin_convertvector(v,bf16x2_t);return __builtin_bit_cast(unsigned,b);}
#define WAIT_BAR(N) asm volatile("s_waitcnt vmcnt(" #N ") lgkmcnt(0)\n\ts_barrier":::"memory")

__device__ __forceinline__ void qkt(f32x16&p0,f32x16&p1,const char*Kslot,const bf16x8*qr,int r32,int hi){
  const char*kb=Kslot+hi*1024+r32*16;
  #pragma unroll
  for(int d0=0;d0<4;++d0){
    const bf16x8 b0=*reinterpret_cast<const bf16x8*>(kb+d0*2048);
    const bf16x8 b1=*reinterpret_cast<const bf16x8*>(kb+d0*2048+512);
    if(d0==0){const f32x16 z_=f32x16{};p0=__builtin_amdgcn_mfma_f32_32x32x16_bf16(b0,qr[0],z_,0,0,0);p1=__builtin_amdgcn_mfma_f32_32x32x16_bf16(b1,qr[0],z_,0,0,0);}
    else{p0=__builtin_amdgcn_mfma_f32_32x32x16_bf16(b0,qr[d0],p0,0,0,0);p1=__builtin_amdgcn_mfma_f32_32x32x16_bf16(b1,qr[d0],p1,0,0,0);}}
}
typedef __attribute__((address_space(3))) const char* lds_cptr;
typedef short v4i16_t __attribute__((ext_vector_type(4)));
__device__ __forceinline__ void kload8(bf16x8*kf,lds_cptr kp){
  kf[0]=*(const __attribute__((address_space(3))) bf16x8*)(kp);      kf[1]=*(const __attribute__((address_space(3))) bf16x8*)(kp+512);
  kf[2]=*(const __attribute__((address_space(3))) bf16x8*)(kp+2048); kf[3]=*(const __attribute__((address_space(3))) bf16x8*)(kp+2560);
  kf[4]=*(const __attribute__((address_space(3))) bf16x8*)(kp+4096); kf[5]=*(const __attribute__((address_space(3))) bf16x8*)(kp+4608);
  kf[6]=*(const __attribute__((address_space(3))) bf16x8*)(kp+6144); kf[7]=*(const __attribute__((address_space(3))) bf16x8*)(kp+6656);
}
__device__ __forceinline__ void kload2(bf16x8*kf,lds_cptr kp,int j){ kf[2*j]=*(const __attribute__((address_space(3))) bf16x8*)(kp+j*2048); kf[2*j+1]=*(const __attribute__((address_space(3))) bf16x8*)(kp+j*2048+512); }
__device__ __forceinline__ s16x4 vtr(lds_cptr p){ return __builtin_bit_cast(s16x4,__builtin_amdgcn_ds_read_tr16_b64_v4i16((__attribute__((address_space(3))) v4i16_t*)p)); }
__device__ __forceinline__ float rowmax(const f32x16&p0,const f32x16&p1){
  float a=max3f(p0[0],p0[1],p1[0]),b=max3f(p0[2],p0[3],p1[1]);a=max3f(a,p1[2],p1[3]);
  #pragma unroll
  for(int r=4;r<16;r+=4){a=max3f(a,p0[r],p0[r+1]);b=max3f(b,p0[r+2],p0[r+3]);a=max3f(a,p1[r],p1[r+1]);b=max3f(b,p1[r+2],p1[r+3]);}
  const float m=max2f(a,b);
  auto rr=__builtin_amdgcn_permlane32_swap(__float_as_uint(m),__float_as_uint(m),false,false);
  return max2f(__uint_as_float(rr[0]),__uint_as_float(rr[1]));
}
__device__ __forceinline__ void pv(f32x16*o,int vb,bf16x8 pa0,bf16x8 pa1,bf16x8 pa2,bf16x8 pa3){
  #pragma unroll
  for(int d0=0;d0<2;++d0){s16x4 lo[4],hi[4];
    #pragma unroll
    for(int ks=0;ks<4;++ks){
      asm volatile("ds_read_b64_tr_b16 %0,%1 offset:%c2":"=&v"(lo[ks]):"v"(vb),"i"(d0*4096+ks*1024):"memory");
      asm volatile("ds_read_b64_tr_b16 %0,%1 offset:%c2":"=&v"(hi[ks]):"v"(vb),"i"(d0*4096+ks*1024+512):"memory");}
    asm volatile("s_waitcnt lgkmcnt(0)":::"memory");SBAR();
    #define PK(k) (bf16x8){lo[k][0],lo[k][1],lo[k][2],lo[k][3],hi[k][0],hi[k][1],hi[k][2],hi[k][3]}
    o[d0]=__builtin_amdgcn_mfma_f32_32x32x16_bf16(pa0,PK(0),o[d0],0,0,0);
    o[d0]=__builtin_amdgcn_mfma_f32_32x32x16_bf16(pa1,PK(1),o[d0],0,0,0);
    o[d0]=__builtin_amdgcn_mfma_f32_32x32x16_bf16(pa2,PK(2),o[d0],0,0,0);
    o[d0]=__builtin_amdgcn_mfma_f32_32x32x16_bf16(pa3,PK(3),o[d0],0,0,0);
    #undef PK
  }
}

#ifndef ATTN_STORE16
#define ATTN_STORE16(p,v) (*(u32x4*)(p)=(v))
#endif
template<int THRL> __device__ __forceinline__ void attn_unit(int b,int h,int hv,int qb,const bf16*Q,const bf16*__restrict__ K,const bf16*__restrict__ V,bf16*O,char*shm){
  const int tid=fresh_tid(),lane=tid&63,r32=lane&31,hi=lane>>5; const int wid=__builtin_amdgcn_readfirstlane(tid>>6);
  const long rowbase=(long)b*SEQ; const int q0=qb*QB;
  const bf16*Qw=Q+(rowbase+q0+wid*QBLK)*DM+h*D;
  const bf16*Kh=K+rowbase*DM+h*D,*Vh=V+rowbase*DM+hv*D;
  const unsigned lds0=(unsigned)(uintptr_t)shm;
  float*wsf=(float*)(shm+LDS_WS)+wid*64;
  const bf16*ksrc=Kh+(long)lane*DM+wid*8;
  const bf16*vsrc=Vh+(long)(16*(wid&3)+(lane>>2))*DM+(wid>>2)*32+(lane&3)*8;
  const unsigned kdst=lds0+LDS_K+wid*1024, vdst=lds0+LDS_V+wid*1024;
  #define DMA_K(t,slot) glds16(ksrc+(long)(t)*KVBLK*DM,(unsigned)__builtin_amdgcn_readfirstlane(kdst+(slot)))
  #define DMA_V(t,slot) do{ glds16(vsrc+(long)(t)*KVBLK*DM,(unsigned)__builtin_amdgcn_readfirstlane(vdst+2*(slot))); glds16(vsrc+(long)(t)*KVBLK*DM+64,(unsigned)__builtin_amdgcn_readfirstlane(vdst+2*(slot)+8192)); }while(0)
  const int vb0=(int)(lds0+LDS_V)+((lane>>4)&1)*32+(lane&3)*8+(4*hi+((lane&15)>>2))*64;
  const char*Kbase=shm+LDS_K; bf16x8 kf[8];
  const lds_cptr shm3=(lds_cptr)shm; const lds_cptr kp0=shm3+LDS_K+hi*1024+r32*16; const lds_cptr vp0=shm3+LDS_V+((lane>>4)&1)*32+(lane&3)*8+(4*hi+((lane&15)>>2))*64;
  const int NT=(q0+QB)/KVBLK;
  DMA_K(0,0);DMA_V(0,0);DMA_K(1,SLOTB);
  bf16x8 qr[4];
  #pragma unroll
  for(int d0=0;d0<4;++d0)qr[d0]=*reinterpret_cast<const bf16x8*>(&Qw[(long)r32*DM+d0*16+hi*8]);
  float mhat=0.f,l_reg=0.f;f32x16 o[4];o[0]=f32x16{};o[1]=f32x16{};o[2]=f32x16{};o[3]=f32x16{};
  const __attribute__((address_space(3))) char* qp0=(const __attribute__((address_space(3))) char*)shm3+LDS_OST+wid*4096+hi*512+r32*16;
  #define QF(d) (*(const __attribute__((address_space(3))) bf16x8*)(qp0+(d)*1024))
  const int qrel=wid*QBLK+r32;
  #define CMASK(P0,P1,t) do{int jb_=(t)-(NT-4); if(jb_>=0)cmask(P0,P1,jb_,qrel,hi);}while(0)
  bool resc=false;
  #define START(P0,P1) do{ const float rm=rowmax(P0,P1); resc=false; \
    { const float dl=rm; mhat=fadd_s(mhat,dl); \
      _Pragma("unroll") for(int r=0;r<16;++r){P0[r]=fsub_s(P0[r],dl);P1[r]=fsub_s(P1[r],dl);} } \
    _Pragma("unroll") for(int r=0;r<16;++r)P0[r]=__builtin_amdgcn_exp2f(P0[r]); }while(0)
  #define RESC() do{ if(resc){ asm volatile("s_waitcnt lgkmcnt(0)":::"memory"); \
      _Pragma("unroll") for(int d_=0;d_<4;++d_) _Pragma("unroll") for(int r=0;r<16;++r)o[d_][r]*=wsf[crow(r,hi)]; } }while(0)
  f32x16 pA0,pA1,pB0,pB1;
  int sl_prev=0,sl_cur=0,sl_next=SLOTB;
  #define ROT() do{sl_prev=sl_cur;sl_cur=sl_next;sl_next=(sl_next==(NSLOT-1)*SLOTB)?0:sl_next+SLOTB;}while(0)
  DMA_K(2,2*SLOTB);
  WAIT_BAR(4);
  qkt(pA0,pA1,Kbase,qr,r32,hi);asm volatile("s_nop 15\n\ts_nop 7":"+v"(pA0),"+v"(pA1));CMASK(pA0,pA1,0);
  { _Pragma("unroll") for(int d0=0;d0<4;++d0)*(__attribute__((address_space(3))) bf16x8*)((__attribute__((address_space(3))) char*)qp0+d0*1024)=qr[d0]; }
  START(pA0,pA1);
  _Pragma("unroll") for(int r=0;r<16;++r)pA1[r]=__builtin_amdgcn_exp2f(pA1[r]);
  WAIT_BAR(0);
  DMA_K(3,0);DMA_V(1,SLOTB);
  ROT();
  kload8(kf,kp0+sl_cur);
  WAIT_BAR(3);
  s16x4 vlo[8],vhi[8]; u32x4 pw0,pw1,pw2,pw3;
  #define PKW(P,B) cvtpk_s(P[B],P[B+1])
  #define PAF(k) __builtin_bit_cast(bf16x8,pw##k)
  #define VFR(i) (bf16x8){vlo[i][0],vlo[i][1],vlo[i][2],vlo[i][3],vhi[i][0],vhi[i][1],vhi[i][2],vhi[i][3]}
  #define PIN(x) asm volatile("":"+v"(x))
  #define MX3(a,b,c) __builtin_fmaxf(__builtin_fmaxf((a),(b)),(c))
  #define GAPA(MF,A0,A1,A2,A3,W0,W1,PW) do{ MF; sacc+=A0; sacc+=A1; sacc+=A2; sacc+=A3; PIN(sacc); W0; W1; PIN(PW); SBAR(); }while(0)
  #define EX(v) __builtin_amdgcn_exp2f(v)
  #define GAPB(MF,X,B) do{ MF; X[B]=EX(X[B]); X[B+1]=EX(X[B+1]); X[B+2]=EX(X[B+2]); X[B+3]=EX(X[B+3]); PIN(X); SBAR(); }while(0)
  #define GAPB2(MF,X,B) do{ MF; X[B]=EX(X[B]); X[B+1]=EX(X[B+1]); PIN(X); SBAR(); }while(0)
  #define VRD2(i) do{ vlo[i]=vtr(vp_+8192+(((i)>>2)*4096+((i)&3)*1024)); vhi[i]=vtr(vp_+8192+(((i)>>2)*4096+((i)&3)*1024+512)); }while(0)
  #define VRD(i) do{ vlo[i]=vtr(vp_+(((i)>>2)*4096+((i)&3)*1024)); vhi[i]=vtr(vp_+(((i)>>2)*4096+((i)&3)*1024+512)); }while(0)
  #define KRD(G,j) do{ if(G){ kload2(kf,kp0+sl_next,j); SBAR(); } }while(0)
  #define STEP(C0,C1,P0,P1,t,GK,GV,GL) do{ SBAR(); \
    const lds_cptr vp_=vp0+2*sl_prev; bf16x8 qa_=QF(0),qb_=QF(1); \
    VRD(0); SBAR(); float sacc=(P0[0]+P0[1]); \
    GAPA(C0=__builtin_amdgcn_mfma_f32_32x32x16_bf16(kf[0],qa_,f32x16{},0,0,0), P0[2],P0[3],P0[4],P0[5],     pw0[0]=PKW(P0,0), pw0[1]=PKW(P0,2), pw0); \
    VRD(4); SBAR(); GAPA(C1=__builtin_amdgcn_mfma_f32_32x32x16_bf16(kf[1],qa_,f32x16{},0,0,0), P0[6],P0[7],P0[8],P0[9],     pw0[2]=PKW(P0,4), pw0[3]=PKW(P0,6), pw0); \
    qa_=QF(2); VRD(1); SBAR(); GAPA(C0=__builtin_amdgcn_mfma_f32_32x32x16_bf16(kf[2],qb_,C0,0,0,0),   P0[10],P0[11],P0[12],P0[13], pw1[0]=PKW(P0,8), pw1[1]=PKW(P0,10), pw1); \
    VRD(5); SBAR(); GAPA(C1=__builtin_amdgcn_mfma_f32_32x32x16_bf16(kf[3],qb_,C1,0,0,0),   P0[14],P0[15],P1[0],P1[1],   pw1[2]=PKW(P0,12),pw1[3]=PKW(P0,14), pw1); \
    qb_=QF(3); VRD(2); SBAR(); GAPA(C0=__builtin_amdgcn_mfma_f32_32x32x16_bf16(kf[4],qa_,C0,0,0,0),   P1[2],P1[3],P1[4],P1[5],     pw2[0]=PKW(P1,0), pw2[1]=PKW(P1,2), pw2); \
    VRD(6); SBAR(); GAPA(C1=__builtin_amdgcn_mfma_f32_32x32x16_bf16(kf[5],qa_,C1,0,0,0),   P1[6],P1[7],P1[8],P1[9],     pw2[2]=PKW(P1,4), pw2[3]=PKW(P1,6), pw2); \
    VRD(3); SBAR(); GAPA(C0=__builtin_amdgcn_mfma_f32_32x32x16_bf16(kf[6],qb_,C0,0,0,0),   P1[10],P1[11],P1[12],P1[13], pw3[0]=PKW(P1,8), pw3[1]=PKW(P1,10), pw3); \
    VRD(7); SBAR(); GAPA(C1=__builtin_amdgcn_mfma_f32_32x32x16_bf16(kf[7],qb_,C1,0,0,0),   P1[14],P1[15],0.f,0.f,       pw3[2]=PKW(P1,12),pw3[3]=PKW(P1,14), pw3); \
    l_reg+=sacc; \
    if(GK){DMA_K((t)+3,sl_cur);} if(GV){DMA_V((t)+1,sl_next);} \
    CMASK(C0,C1,t); \
    { float a=MX3(C0[0],C0[1],C1[0]),b=MX3(C0[2],C0[3],C1[1]); a=MX3(a,C1[2],C1[3]); \
      _Pragma("unroll") for(int r=4;r<16;r+=4){a=MX3(a,C0[r],C0[r+1]);b=MX3(b,C0[r+2],C0[r+3]);a=MX3(a,C1[r],C1[r+1]);b=MX3(b,C1[r+2],C1[r+3]);} \
      float rm=__builtin_fmaxf(a,b); { auto rr=__builtin_amdgcn_permlane32_swap(__float_as_uint(rm),__float_as_uint(rm),false,false); rm=__builtin_fmaxf(__uint_as_float(rr[0]),__uint_as_float(rr[1])); } \
      resc=false; rm-=mhat; \
      if(__builtin_expect(__any(rm>(float)THRL),0)){ const float dl=__builtin_fmaxf(rm,0.f); mhat+=dl; \
        const float f=__builtin_amdgcn_exp2f(-dl); l_reg*=f; if(hi==0)wsf[r32]=f; resc=true; } \
      C0=C0-mhat; C1=C1-mhat; } \
    SBAR(); \
    GAPB2(o[0]=__builtin_amdgcn_mfma_f32_32x32x16_bf16(PAF(0),VFR(0),o[0],0,0,0), C0,0);  VRD2(0); SBAR(); \
    GAPB2(o[1]=__builtin_amdgcn_mfma_f32_32x32x16_bf16(PAF(0),VFR(4),o[1],0,0,0), C0,2);  VRD2(4); SBAR(); \
    KRD(GL,0); GAPB2(o[0]=__builtin_amdgcn_mfma_f32_32x32x16_bf16(PAF(1),VFR(1),o[0],0,0,0), C0,4);  VRD2(1); SBAR(); \
    KRD(GL,1); GAPB2(o[1]=__builtin_amdgcn_mfma_f32_32x32x16_bf16(PAF(1),VFR(5),o[1],0,0,0), C0,6);  VRD2(5); SBAR(); \
    KRD(GL,2); GAPB2(o[0]=__builtin_amdgcn_mfma_f32_32x32x16_bf16(PAF(2),VFR(2),o[0],0,0,0), C0,8);  VRD2(2); SBAR(); \
    KRD(GL,3); GAPB2(o[1]=__builtin_amdgcn_mfma_f32_32x32x16_bf16(PAF(2),VFR(6),o[1],0,0,0), C0,10); VRD2(6); SBAR(); \
    GAPB2(o[0]=__builtin_amdgcn_mfma_f32_32x32x16_bf16(PAF(3),VFR(3),o[0],0,0,0), C0,12); VRD2(3); SBAR(); \
    GAPB2(o[1]=__builtin_amdgcn_mfma_f32_32x32x16_bf16(PAF(3),VFR(7),o[1],0,0,0), C0,14); VRD2(7); SBAR(); \
    GAPB2(o[2]=__builtin_amdgcn_mfma_f32_32x32x16_bf16(PAF(0),VFR(0),o[2],0,0,0), C1,0); \
    GAPB2(o[3]=__builtin_amdgcn_mfma_f32_32x32x16_bf16(PAF(0),VFR(4),o[3],0,0,0), C1,2); \
    GAPB2(o[2]=__builtin_amdgcn_mfma_f32_32x32x16_bf16(PAF(1),VFR(1),o[2],0,0,0), C1,4); \
    GAPB2(o[3]=__builtin_amdgcn_mfma_f32_32x32x16_bf16(PAF(1),VFR(5),o[3],0,0,0), C1,6); \
    GAPB2(o[2]=__builtin_amdgcn_mfma_f32_32x32x16_bf16(PAF(2),VFR(2),o[2],0,0,0), C1,8); \
    GAPB2(o[3]=__builtin_amdgcn_mfma_f32_32x32x16_bf16(PAF(2),VFR(6),o[3],0,0,0), C1,10); \
    GAPB2(o[2]=__builtin_amdgcn_mfma_f32_32x32x16_bf16(PAF(3),VFR(3),o[2],0,0,0), C1,12); \
    GAPB2(o[3]=__builtin_amdgcn_mfma_f32_32x32x16_bf16(PAF(3),VFR(7),o[3],0,0,0), C1,14); \
    }while(0)
  int t=1;
  #undef CMASK
  #define CMASK(P0,P1,t) do{}while(0)
  for(;t+5<NT;t+=2){
    STEP(pB0,pB1,pA0,pA1,t,true,true,true);     WAIT_BAR(3); RESC(); ROT();
    STEP(pA0,pA1,pB0,pB1,t+1,true,true,true);   WAIT_BAR(3); RESC(); ROT();
  }
  #undef CMASK
  #define CMASK(P0,P1,t) do{int jb_=(t)-(NT-4); if(jb_>=0)cmask(P0,P1,jb_,qrel,hi);}while(0)
  #define ENDW(tt) do{ if((tt)+3<NT){WAIT_BAR(3);} else if((tt)+2<NT){WAIT_BAR(2);} else {WAIT_BAR(0);} }while(0)
  for(;t+1<NT;t+=2){
    STEP(pB0,pB1,pA0,pA1,t,(t+3<NT),(t+1<NT),(t+1<NT));       ENDW(t);   RESC(); ROT();
    STEP(pA0,pA1,pB0,pB1,t+1,(t+4<NT),(t+2<NT),(t+2<NT));     ENDW(t+1); RESC(); ROT();
  }
  STEP(pB0,pB1,pA0,pA1,NT-1,false,false,false); RESC();
  { float sacc=pB0[0]+pB0[1]; _Pragma("unroll") for(int r=2;r<16;++r)sacc+=pB0[r]; _Pragma("unroll") for(int r=0;r<16;++r)sacc+=pB1[r]; l_reg+=sacc;
    pw0=(u32x4){PKW(pB0,0),PKW(pB0,2),PKW(pB0,4),PKW(pB0,6)};pw1=(u32x4){PKW(pB0,8),PKW(pB0,10),PKW(pB0,12),PKW(pB0,14)};pw2=(u32x4){PKW(pB1,0),PKW(pB1,2),PKW(pB1,4),PKW(pB1,6)};pw3=(u32x4){PKW(pB1,8),PKW(pB1,10),PKW(pB1,12),PKW(pB1,14)};
    SBAR(); pv(o,vb0+2*sl_cur,PAF(0),PAF(1),PAF(2),PAF(3)); pv(o+2,vb0+2*sl_cur+8192,PAF(0),PAF(1),PAF(2),PAF(3)); }
  #undef PKW
  #undef PAF
  #undef VFR
  #undef PIN
  #undef MX3
  #undef GAPA
  #undef GAPB
  #undef EX
  #undef VRD
  #undef KRD
  #undef STEP
  #undef ENDW
  {auto rr=__builtin_amdgcn_permlane32_swap(__float_as_uint(l_reg),__float_as_uint(l_reg),false,false);l_reg=__uint_as_float(rr[0])+__uint_as_float(rr[1]);}
  if(hi==0)wsf[32+r32]=l_reg;asm volatile("s_waitcnt lgkmcnt(0)":::"memory");
  float rli[16];
  #pragma unroll
  for(int r=0;r<16;++r)rli[r]=__builtin_amdgcn_rcpf(wsf[32+crow(r,hi)]);
  bf16*Ow=O+(rowbase+q0+wid*QBLK)*DM+hv*D;
  { bf16*stg=(bf16*)(shm+LDS_OST)+wid*2048;
    #pragma unroll
    for(int e=0;e<2;++e){
    #pragma unroll
    for(int r=0;r<16;++r){const int orow=crow(r,hi);
      #pragma unroll
      for(int d0=0;d0<2;++d0)stg[orow*64+d0*32+r32]=__float2bfloat16(o[2*e+d0][r]*rli[r]);}
    asm volatile("s_waitcnt lgkmcnt(0)":::"memory");
    #pragma unroll
    for(int i=0;i<4;++i){const int row=i*8+(lane>>3),ch=lane&7; const u32x4 v=*(const u32x4*)(stg+row*64+ch*8); ATTN_STORE16(Ow+(long)row*DM+e*64+ch*8,v);}
    asm volatile("s_waitcnt lgkmcnt(0)":::"memory"); } }
  asm volatile("s_waitcnt lgkmcnt(0)\n\ts_barrier":::"memory");
  #undef DMA_K
  #undef DMA_V
  #undef QF
  #undef CMASK
  #undef START
  #undef RESC
  #undef ROT
}
constexpr int ATTN_LDS_BYTES=LDS_BYTES;
#undef SBAR
#undef WAIT_BAR
}
#define LAS __attribute__((address_space(3)))
typedef unsigned short bf16;
typedef unsigned v4u __attribute__((ext_vector_type(4)));
typedef float f32x4 __attribute__((ext_vector_type(4)));
typedef float f32x16 __attribute__((ext_vector_type(16)));
typedef short bf16x8 __attribute__((ext_vector_type(8)));
constexpr int NWAVES = 8, NTHR = 512;
constexpr int NB = 4, SEQ = 8192, DM = 1024, TT = NB * SEQ, TH = 16384, FF = 4096, NIN = 9216;
constexpr float EPS = 1e-6f;
constexpr size_t MiB = 1u << 20;
constexpr size_t WS_ADA = 0, WS_ROPE = 1 * MiB, WS_BAR = 3 * MiB, WS_WIN = 4 * MiB, WS_WPA = 22 * MiB, WS_WPR = 24 * MiB, WS_WOUT = 26 * MiB, WS_W1 = 28 * MiB, WS_W2 = 36 * MiB;
constexpr size_t WS_XN = 44 * MiB, WS_Y = 108 * MiB, WS_P = 172 * MiB, WS_DEC = 460 * MiB, WS_END = 462 * MiB;
constexpr size_t PBUF = (size_t)TH * 1024;
constexpr size_t DO_O0 = 0, DO_O1 = 32 * MiB, DO_UST = 64 * MiB;
constexpr int LDS_BYTES = 147456;

#define LDS_WAIT() asm volatile("s_waitcnt lgkmcnt(0)" ::: "memory")
__device__ __forceinline__ unsigned f2bf(float f) { unsigned u = __builtin_bit_cast(unsigned, f); return (u + 0x7fffu + ((u >> 16) & 1u)) >> 16; }
__device__ __forceinline__ unsigned pk2(float lo, float hi) { return f2bf(lo) | (f2bf(hi) << 16); }
__device__ __forceinline__ float bflo(unsigned w) { return __uint_as_float(w << 16); }
__device__ __forceinline__ float bfhi(unsigned w) { return __uint_as_float(w & 0xffff0000u); }
__device__ __forceinline__ float wave_sum(float v) {
#pragma unroll
    for (int o = 1; o < 64; o <<= 1) v += __shfl_xor(v, o);
    return v;
}
struct Args { const float* in[21]; const int* pos; float* out; unsigned char* ws; };

__device__ __forceinline__ void p0_transpose_item(const float* W, int K, int N, bf16* WT, LAS float* scr, int item, int lane) {
    const int nblk = N / 32, kb = item / nblk, nb = item % nblk, k0 = 64 * kb, n0 = 32 * nb;
#pragma unroll 8
    for (int i = 0; i < 32; ++i) { const int kk = 2 * i + (lane >> 5); scr[kk * 33 + (lane & 31)] = W[(size_t)(k0 + kk) * N + n0 + (lane & 31)]; }
    LDS_WAIT(); asm volatile("" ::: "memory");
    const int c = lane & 7;
#pragma unroll
    for (int j = 0; j < 4; ++j) { const int n = (lane >> 3) + 8 * j; const LAS float* s = scr + (8 * c) * 33 + n;
        v4u o; o.x = pk2(s[0 * 33], s[1 * 33]); o.y = pk2(s[2 * 33], s[3 * 33]); o.z = pk2(s[4 * 33], s[5 * 33]); o.w = pk2(s[6 * 33], s[7 * 33]);
        *(v4u*)(WT + (size_t)(n0 + n) * K + k0 + 8 * c) = o; }
    LDS_WAIT(); asm volatile("" ::: "memory");
}

__device__ __forceinline__ void norm_mod_row(const float* xrow, const float* w, const float* sc, const float* sh, bf16* orow, int lane) {
    const f32x4* xr = (const f32x4*)xrow + lane;
    f32x4 v[4]; float s = 0.f;
#pragma unroll
    for (int j = 0; j < 4; ++j) { v[j] = xr[64 * j]; s += (v[j].x * v[j].x + v[j].y * v[j].y) + (v[j].z * v[j].z + v[j].w * v[j].w); }
    const float rinv = 1.0f / sqrtf(wave_sum(s) * (1.f / 1024.f) + EPS);
    unsigned long long* o8 = (unsigned long long*)orow + lane;
#pragma unroll
    for (int j = 0; j < 4; ++j) {
        const f32x4 wv = ((const f32x4*)w)[lane + 64 * j], scv = ((const f32x4*)sc)[lane + 64 * j], shv = ((const f32x4*)sh)[lane + 64 * j];
        const f32x4 o = v[j] * rinv * wv * (scv + 1.0f) + shv;
        o8[64 * j] = (unsigned long long)pk2(o.x, o.y) | ((unsigned long long)pk2(o.z, o.w) << 32);
    }
}

#define XB_TMO      128
#define XB_XCNT(j)  (256  + 64 * (j))
#define XB_XSUB(j)  (1280 + 64 * (j))
#define XB_XGEN(j)  (2304 + 64 * (j))
#define XB_TOP      3328
#define XB_TOPGEN   3392
#define XCD_BAR_WORDS 3456
#define XB_SPIN_CAP (1u << 18)

__device__ __forceinline__ unsigned xb_ld(unsigned* p)              { return __hip_atomic_load(p, __ATOMIC_RELAXED, __HIP_MEMORY_SCOPE_AGENT); }
__device__ __forceinline__ unsigned xb_add(unsigned* p, unsigned v) { return __hip_atomic_fetch_add(p, v, __ATOMIC_RELAXED, __HIP_MEMORY_SCOPE_AGENT); }
__device__ __forceinline__ unsigned xb_xcc_id() { return (unsigned)__builtin_amdgcn_s_getreg((3 << 11) | 20) & 0xFu; }
#define XB_SPIN(cond, bar) do { unsigned _sp = 0; while (cond) { __builtin_amdgcn_s_sleep(1); \
    if ((++_sp & 255u) == 0u) { if (xb_ld(&(bar)[XB_TMO])) break; if (_sp > XB_SPIN_CAP) { atomicAdd(&(bar)[XB_TMO], 1u); break; } } } } while (0)

struct XcdBarrier {
    unsigned* bar; unsigned x;
    volatile LAS unsigned* st;
};

__device__ __forceinline__ XcdBarrier xcd_barrier_post(unsigned* bar, volatile LAS unsigned* st) {
    XcdBarrier b; b.bar = bar; b.x = xb_xcc_id(); b.st = st;
    if (threadIdx.x == 0) (void)xb_add(&bar[XB_XCNT(b.x)], 1u);
    return b;
}
__device__ __forceinline__ void xcd_barrier_complete(unsigned* bar, unsigned x, unsigned& nloc, unsigned& nx) {
    const unsigned G = gridDim.x * gridDim.y * gridDim.z;
    unsigned sum, cnt, mine, sp = 0u;
    for (;;) {
        sum = 0u; cnt = 0u; mine = 0u;
#pragma unroll
        for (unsigned j = 0; j < 16; ++j) { const unsigned c = xb_ld(&bar[XB_XCNT(j)]); sum += c; cnt += (c > 0u) ? 1u : 0u; mine = (j == x) ? c : mine; }
        if (sum == G) break;
        __builtin_amdgcn_s_sleep(1);
        if ((++sp & 255u) == 0u) { if (xb_ld(&bar[XB_TMO])) break; if (sp > XB_SPIN_CAP) { atomicAdd(&bar[XB_TMO], 1u); break; } }
    }
    nloc = mine > 0u ? mine : 1u; nx = cnt > 0u ? cnt : 1u;
}

__device__ __forceinline__ void xcd_barrier(const XcdBarrier& b) {
    asm volatile("s_waitcnt vmcnt(0)" ::: "memory");
    __syncthreads();
    if (threadIdx.x == 0) {
        unsigned* bar = b.bar; const unsigned bx_ = (unsigned)__builtin_amdgcn_readfirstlane((int)xb_xcc_id());
        __builtin_amdgcn_s_waitcnt(0);
        unsigned nloc = b.st[0], nx = b.st[1];
        if (nloc == 0u) { xcd_barrier_complete(bar, bx_, nloc, nx); b.st[0] = nloc; b.st[1] = nx; }
        const unsigned old = xb_add(&bar[XB_XSUB(bx_)], 1u);
        const unsigned gen = old / nloc;
        if (old + 1u == (gen + 1u) * nloc) {
            __builtin_amdgcn_fence(__ATOMIC_RELEASE, "agent");
            asm volatile("s_waitcnt vmcnt(0)" ::: "memory");
            const unsigned og = xb_add(&bar[XB_TOP], 1u);
            const unsigned tg = og / nx;
            if (og + 1u == (tg + 1u) * nx) xb_add(&bar[XB_TOPGEN], 1u);
            else XB_SPIN(xb_ld(&bar[XB_TOPGEN]) == tg, bar);
            __builtin_amdgcn_fence(__ATOMIC_ACQUIRE, "agent");
            xb_add(&bar[XB_XGEN(bx_)], 1u);
            asm volatile("s_waitcnt vmcnt(0)" ::: "memory");
        } else {
            XB_SPIN(xb_ld(&bar[XB_XGEN(bx_)]) == gen, bar);
            __builtin_amdgcn_fence(__ATOMIC_ACQUIRE, "agent");
            asm volatile("s_waitcnt vmcnt(0)" ::: "memory");
        }
    }
    __syncthreads();
}

constexpr int HG_G = 0, HG_TOT = 33792, HG_QP = 35840, HG_KP = 53248, HG_QPP = 70656, HG_VT = 88064, HG_PP = 106496, HG_RED = 115712;
constexpr int GST = 132;
__device__ __forceinline__ int crow(int r, int hi) { return (r & 3) + 8 * (r >> 2) + 4 * hi; }


__device__ __forceinline__ void ld8(const LAS float* p, float (&o)[8]) { const f32x4 a = *(const LAS f32x4*)p, b = *(const LAS f32x4*)(p + 4); o[0] = a[0]; o[1] = a[1]; o[2] = a[2]; o[3] = a[3]; o[4] = b[0]; o[5] = b[1]; o[6] = b[2]; o[7] = b[3]; }
__device__ __forceinline__ bf16x8 ldsfrag(const LAS unsigned char* p) { return *(const LAS bf16x8*)p; }
__device__ __forceinline__ bf16x8 gather8(const LAS bf16* p, int st) {
    bf16x8 r;
#pragma unroll
    for (int i = 0; i < 8; ++i) r[i] = (short)p[i * st];
    return r;
}
constexpr int RS = 136;

struct HgIn1 { v4u f[2], v[2]; };
__device__ __forceinline__ void hg_load1(HgIn1& L, const bf16* RF, const bf16* RI, int unit, int tid) {
    const int bl = unit >> 10, h = (unit >> 7) & 7, c = unit & 127;
    const size_t off = ((size_t)bl * SEQ + (size_t)c * 64) * 1024 + h * 128 + (size_t)(tid >> 4) * 1024 + (tid & 15) * 8;
#pragma unroll
    for (int p = 0; p < 2; ++p) { L.f[p] = *(const v4u*)(RF + off + (size_t)p * 32 * 1024); L.v[p] = *(const v4u*)(RI + off + (size_t)p * 32 * 1024); }
}
__device__ __forceinline__ void hg_gates2(LAS unsigned char* lds, const v4u (&fw)[2], const float* lbl, int h, int tid, float (&kk)[2][8]) {
    const int r0 = tid >> 4, c8 = (tid & 15) * 8;
    LAS float* G = (LAS float*)(lds + HG_G); LAS float* TOT = (LAS float*)(lds + HG_TOT);
    float lb[8];
#pragma unroll
    for (int i = 0; i < 8; ++i) { const int c = h * 128 + c8 + i; lb[i] = 1.0f / (1.0f + __expf(lbl[c] - lbl[1024 + c])); }
#pragma unroll
    for (int p = 0; p < 2; ++p) {
        const int r = r0 + 32 * p; const v4u w = fw[p];
        float x[8] = {bflo(w.x), bfhi(w.x), bflo(w.y), bfhi(w.y), bflo(w.z), bfhi(w.z), bflo(w.w), bfhi(w.w)};
        float g[8];
#pragma unroll
        for (int i = 0; i < 8; ++i) { const float sg = 1.0f / (1.0f + __expf(-x[i])); const float f = lb[i] + (1.0f - lb[i]) * sg; g[i] = __logf(f); kk[p][i] = (1.0f - lb[i]) * (1.0f - sg); }
        *(LAS f32x4*)(G + r * GST + c8) = (f32x4){g[0], g[1], g[2], g[3]};
        *(LAS f32x4*)(G + r * GST + c8 + 4) = (f32x4){g[4], g[5], g[6], g[7]};
    }
    __syncthreads();
    {
        const int k = tid & 127, seg = tid >> 7; float v[16];
#pragma unroll
        for (int i = 0; i < 16; ++i) v[i] = G[(seg * 16 + i) * GST + k];
#pragma unroll
        for (int i = 1; i < 16; ++i) v[i] += v[i - 1];
        TOT[seg * 128 + k] = v[15];
        __syncthreads();
        float off = 0.f;
#pragma unroll
        for (int s = 0; s < 3; ++s) if (s < seg) off += TOT[s * 128 + k];
#pragma unroll
        for (int i = 0; i < 16; ++i) G[(seg * 16 + i) * GST + k] = v[i] + off;
    }
    __syncthreads();
}

__device__ __forceinline__ void hg_unit_state(LAS unsigned char* lds, const HgIn1& L, const float* lbl, bf16* Ust, float* dec, int unit, int tid) {
    const int h = (unit >> 7) & 7;
    const int r0 = tid >> 4, c8 = (tid & 15) * 8, lane = tid & 63, wid = tid >> 6, r32 = lane & 31, hi = lane >> 5;
    float kk[2][8];
    hg_gates2(lds, L.f, lbl, h, tid, kk);
    const LAS float* G = (const LAS float*)(lds + HG_G);
    float bl8[8]; ld8(G + 63 * GST + c8, bl8);
#pragma unroll
    for (int p = 0; p < 2; ++p) {
        const int r = r0 + 32 * p; float b8[8]; ld8(G + r * GST + c8, b8); float kp[8];
#pragma unroll
        for (int i = 0; i < 8; ++i) kp[i] = kk[p][i] * __expf(bl8[i] - b8[i]);
        *(LAS v4u*)(lds + HG_KP + (r * RS + c8) * 2) = (v4u){pk2(kp[0], kp[1]), pk2(kp[2], kp[3]), pk2(kp[4], kp[5]), pk2(kp[6], kp[7])};
        *(LAS v4u*)(lds + HG_VT + (r * RS + c8) * 2) = L.v[p];
    }
    if (tid < 128) dec[(size_t)unit * 128 + tid] = __expf(G[63 * GST + tid]);
    __syncthreads();
    const int jb = wid >> 1, kb0 = (wid & 1) * 2;
    const LAS bf16* VS = (const LAS bf16*)(lds + HG_VT); const LAS bf16* KS = (const LAS bf16*)(lds + HG_KP);
    f32x16 a0 = {}, a1 = {};
#pragma unroll 1
    for (int ks = 0; ks < 4; ++ks) {
        const int s0 = ks * 16 + hi * 8;
        const bf16x8 av = gather8(VS + s0 * RS + jb * 32 + r32, RS);
        const bf16x8 b0 = gather8(KS + s0 * RS + kb0 * 32 + r32, RS);
        const bf16x8 b1 = gather8(KS + s0 * RS + (kb0 + 1) * 32 + r32, RS);
        a0 = __builtin_amdgcn_mfma_f32_32x32x16_bf16(av, b0, a0, 0, 0, 0);
        a1 = __builtin_amdgcn_mfma_f32_32x32x16_bf16(av, b1, a1, 0, 0, 0);
    }
    LAS bf16* STG = (LAS bf16*)lds;
#pragma unroll
    for (int r = 0; r < 16; ++r) { const int j = jb * 32 + crow(r, hi);
        STG[j * RS + kb0 * 32 + r32] = (bf16)f2bf(a0[r]); STG[j * RS + (kb0 + 1) * 32 + r32] = (bf16)f2bf(a1[r]); }
    __syncthreads();
    bf16* up = Ust + (size_t)unit * 16384;
#pragma unroll
    for (int i = 0; i < 4; ++i) { const int p = tid + 512 * i, j = p >> 4, cc = (p & 15) * 8;
        *(v4u*)(up + j * 128 + cc) = *(const LAS v4u*)(lds + (j * RS + cc) * 2); }
    __syncthreads();
}

struct HgIn3 { v4u q[2], f[2], v[2]; };
struct HgLate3 { v4u g[2], s[8]; };
__device__ __forceinline__ void hg_load3(HgIn3& L, const bf16* RQ, const bf16* RF, const bf16* RI, const bf16* RG, const bf16* Sin, int unit, int tid) {
    const int bl = unit >> 10, h = (unit >> 7) & 7, c = unit & 127;
    const size_t off = ((size_t)bl * SEQ + (size_t)c * 64) * 1024 + h * 128 + (size_t)(tid >> 4) * 1024 + (tid & 15) * 8;
#pragma unroll
    for (int p = 0; p < 2; ++p) { const size_t o = off + (size_t)p * 32 * 1024; L.q[p] = *(const v4u*)(RQ + o); L.f[p] = *(const v4u*)(RF + o); L.v[p] = *(const v4u*)(RI + o); }
}
__device__ __forceinline__ void hg_load3_g(HgLate3& L, const bf16* RG, int unit, int tid) {
    const int bl = unit >> 10, h = (unit >> 7) & 7, c = unit & 127;
    const size_t off = ((size_t)bl * SEQ + (size_t)c * 64) * 1024 + h * 128 + (size_t)(tid >> 4) * 1024 + (tid & 15) * 8;
#pragma unroll
    for (int p = 0; p < 2; ++p) L.g[p] = *(const v4u*)(RG + off + (size_t)p * 32 * 1024);
}
__device__ __forceinline__ void hg_load3_s(HgLate3& L, const bf16* Sin, int unit, int tid) {
    const int lane = tid & 63, wid = tid >> 6, jb = wid >> 1;
    const bf16* sp = Sin + (size_t)unit * 16384 + (size_t)(jb * 32 + (lane & 31)) * 128 + (lane >> 5) * 8;
#pragma unroll
    for (int ks = 0; ks < 8; ++ks) L.s[ks] = *(const v4u*)(sp + ks * 16);
}
__device__ __forceinline__ void hg_unit_out(LAS unsigned char* lds, bf16* RQ, const HgIn3& L, const bf16* RG, const bf16* Sin, const float* lbl, const float* rnw, int unit, int tid) {
    const int bl = unit >> 10, h = (unit >> 7) & 7, c = unit & 127;
    const size_t tile_off = ((size_t)bl * SEQ + (size_t)c * 64) * 1024 + h * 128;
    const int r0 = tid >> 4, c8 = (tid & 15) * 8, lane = tid & 63, wid = tid >> 6, r32 = lane & 31, hi = lane >> 5;
    const int tb = wid & 1, jb = wid >> 1;
    HgLate3 LL;
    float kk[2][8];
    hg_gates2(lds, L.f, lbl, h, tid, kk);
    hg_load3_s(LL, Sin, unit, tid);
    const LAS float* G = (const LAS float*)(lds + HG_G);
    float bm8[8]; ld8(G + 31 * GST + c8, bm8);
#pragma unroll
    for (int p = 0; p < 2; ++p) {
        const int r = r0 + 32 * p; float b8[8]; ld8(G + r * GST + c8, b8);
        const v4u qq = L.q[p];
        const float q8[8] = {bflo(qq.x), bfhi(qq.x), bflo(qq.y), bfhi(qq.y), bflo(qq.z), bfhi(qq.z), bflo(qq.w), bfhi(qq.w)};
        float qp[8], kp[8], qpp[8];
#pragma unroll
        for (int i = 0; i < 8; ++i) { const float e = __expf(b8[i] - bm8[i]); qp[i] = q8[i] * e; kp[i] = kk[p][i] * __expf(bm8[i] - b8[i]); qpp[i] = q8[i] * __expf(b8[i]); }
        *(LAS v4u*)(lds + HG_QP + (r * RS + c8) * 2) = (v4u){pk2(qp[0], qp[1]), pk2(qp[2], qp[3]), pk2(qp[4], qp[5]), pk2(qp[6], qp[7])};
        *(LAS v4u*)(lds + HG_KP + (r * RS + c8) * 2) = (v4u){pk2(kp[0], kp[1]), pk2(kp[2], kp[3]), pk2(kp[4], kp[5]), pk2(kp[6], kp[7])};
        *(LAS v4u*)(lds + HG_QPP + (r * RS + c8) * 2) = (v4u){pk2(qpp[0], qpp[1]), pk2(qpp[2], qpp[3]), pk2(qpp[4], qpp[5]), pk2(qpp[6], qpp[7])};
        *(LAS v4u*)(lds + HG_VT + (r * RS + c8) * 2) = L.v[p];
    }
    __syncthreads();
    if (wid < 4) {
        const int stb = wid & 1, ssb = wid >> 1;
        f32x16 sc = {};
        if (ssb <= stb) {
#pragma unroll
            for (int ks = 0; ks < 8; ++ks) {
                const bf16x8 av = ldsfrag(lds + HG_QP + ((stb * 32 + r32) * RS + ks * 16 + hi * 8) * 2);
                const bf16x8 bv = ldsfrag(lds + HG_KP + ((ssb * 32 + r32) * RS + ks * 16 + hi * 8) * 2);
                sc = __builtin_amdgcn_mfma_f32_32x32x16_bf16(av, bv, sc, 0, 0, 0);
            }
        }
        LAS bf16* PP = (LAS bf16*)(lds + HG_PP);
        const int s = ssb * 32 + r32;
#pragma unroll
        for (int r = 0; r < 16; ++r) { const int t = stb * 32 + crow(r, hi); const float v = (ssb <= stb && s <= t) ? sc[r] : 0.f; PP[t * 72 + s] = (bf16)f2bf(v); }
    }
    __syncthreads();
    hg_load3_g(LL, RG, unit, tid);
    f32x16 o = {};
    const LAS bf16* VS = (const LAS bf16*)(lds + HG_VT);
#pragma unroll
    for (int ks = 0; ks < 4; ++ks) {
        const bf16x8 av = ldsfrag(lds + HG_PP + ((tb * 32 + r32) * 72 + ks * 16 + hi * 8) * 2);
        const bf16x8 bv = gather8(VS + (ks * 16 + hi * 8) * RS + jb * 32 + r32, RS);
        o = __builtin_amdgcn_mfma_f32_32x32x16_bf16(av, bv, o, 0, 0, 0);
    }
#pragma unroll
    for (int ks = 0; ks < 8; ++ks) {
        const bf16x8 av = ldsfrag(lds + HG_QPP + ((tb * 32 + r32) * RS + ks * 16 + hi * 8) * 2);
        o = __builtin_amdgcn_mfma_f32_32x32x16_bf16(av, __builtin_bit_cast(bf16x8, LL.s[ks]), o, 0, 0, 0);
    }
    LAS float* RED = (LAS float*)(lds + HG_RED);
    float ssq[16];
#pragma unroll
    for (int r = 0; r < 16; ++r) { float s = o[r] * o[r]; s += __shfl_xor(s, 1); s += __shfl_xor(s, 2); s += __shfl_xor(s, 4); s += __shfl_xor(s, 8); s += __shfl_xor(s, 16); ssq[r] = s; }
    if (r32 == 0) {
#pragma unroll
        for (int r = 0; r < 16; ++r) RED[jb * 64 + tb * 32 + crow(r, hi)] = ssq[r];
    }
    __syncthreads();
    {
        LAS float* STG = (LAS float*)lds;
        const int j = jb * 32 + r32; const float wj = rnw[j];
#pragma unroll
        for (int r = 0; r < 16; ++r) {
            const int t = tb * 32 + crow(r, hi);
            const float tot = RED[t] + RED[64 + t] + RED[128 + t] + RED[192 + t];
            const float rstd = 1.0f / sqrtf(tot * (1.f / 128.f) + EPS);
            STG[t * GST + j] = o[r] * rstd * wj;
        }
    }
    __syncthreads();
#pragma unroll
    for (int p = 0; p < 2; ++p) {
        const int r = r0 + 32 * p; float v8[8]; ld8((const LAS float*)lds + r * GST + c8, v8);
        const v4u gg = LL.g[p];
        const float g8[8] = {bflo(gg.x), bfhi(gg.x), bflo(gg.y), bfhi(gg.y), bflo(gg.z), bfhi(gg.z), bflo(gg.w), bfhi(gg.w)};
#pragma unroll
        for (int i = 0; i < 8; ++i) v8[i] *= g8[i] / (1.0f + __expf(-g8[i]));
        *(v4u*)(RQ + tile_off + (size_t)r * 1024 + c8) = (v4u){pk2(v8[0], v8[1]), pk2(v8[2], v8[3]), pk2(v8[4], v8[5]), pk2(v8[6], v8[7])};
    }
    __syncthreads();
}

__global__ void __launch_bounds__(NTHR, 2) fused_fwd(Args args) {
    extern __shared__ __attribute__((aligned(16))) unsigned char lds_raw[];
    cg::grid_group grid = cg::this_grid();
    LAS unsigned char* lds = (LAS unsigned char*)lds_raw;
    const int tid = threadIdx.x, lane = tid & 63, wave = __builtin_amdgcn_readfirstlane(tid >> 6);
    const int G = gridDim.x, bx = blockIdx.x;
    const int vcu = (G % 8 == 0) ? (bx % 8) * (G / 8) + bx / 8 : bx;
    const int gw = vcu * NWAVES + wave, NGW = G * NWAVES;
    unsigned char* ws = args.ws;
    const float* x = args.in[0]; const float* cvec = args.in[1];
    const float* w_ada = args.in[3]; const float* b_ada = args.in[4]; const float* norm_mix = args.in[5]; const float* w_in = args.in[6];
    const float* lam_q1 = args.in[7]; const float* lam_k1 = args.in[8]; const float* lam_q2 = args.in[9]; const float* lam_k2 = args.in[10];
    const float* subln_w = args.in[11]; const float* lb_logits = args.in[12]; const float* rec_norm_w = args.in[13];
    const float* w_pa = args.in[14]; const float* w_pr = args.in[15]; const float* w_out = args.in[16]; const float* norm_mlp = args.in[17];
    const float* w1 = args.in[18]; const float* w2 = args.in[19]; const float* norm_final = args.in[20];
    float* ada = (float*)(ws + WS_ADA); float* rope = (float*)(ws + WS_ROPE);
    bf16* Win_t = (bf16*)(ws + WS_WIN); bf16* Wpa_t = (bf16*)(ws + WS_WPA); bf16* Wpr_t = (bf16*)(ws + WS_WPR); bf16* Wout_t = (bf16*)(ws + WS_WOUT);
    bf16* W1_t = (bf16*)(ws + WS_W1); bf16* W2_t = (bf16*)(ws + WS_W2);
    bf16* XN = (bf16*)(ws + WS_XN); bf16* Y = (bf16*)(ws + WS_Y); bf16* P = (bf16*)(ws + WS_P); float* dec = (float*)(ws + WS_DEC);
    bf16* Pq = P, *Pk = P + PBUF, *Pv = P + 2 * PBUF, *Prq = P + 3 * PBUF, *Prf = P + 4 * PBUF, *Pri = P + 5 * PBUF, *Prg = P + 6 * PBUF, *Pga = P + 7 * PBUF, *Pgr = P + 8 * PBUF;
    float* Y1 = (float*)P;
    bf16* Oa = Pv;
    bf16* UH = P;
    unsigned char* dob = (unsigned char*)args.out;
    bf16* O0 = (bf16*)(dob + DO_O0); bf16* O1 = (bf16*)(dob + DO_O1); bf16* Ust = (bf16*)(dob + DO_UST);

    unsigned* barw = (unsigned*)(ws + WS_BAR);
    if (bx == 0) for (int i = tid; i < XCD_BAR_WORDS; i += NTHR) barw[i] = 0u;
    volatile LAS unsigned* bst = (volatile LAS unsigned*)(lds + 131072 + 512);
    if (tid < 2) bst[tid] = 0u;
    __syncthreads();
    if (bx < 96) {
        LAS float* scs = (LAS float*)lds;
        LAS float* part = (LAS float*)(lds + 16384);
        for (int i = tid; i < 4096; i += NTHR) { const float v = cvec[i]; scs[i] = v / (1.0f + __expf(-v)); }
        __syncthreads();
        const int n = bx * 64 + lane; float a0 = 0.f, a1 = 0.f, a2 = 0.f, a3 = 0.f;
        const float* wp = w_ada + (size_t)(wave * 128) * 6144 + n;
#pragma unroll 8
        for (int k = 0; k < 128; ++k) { const float wv = wp[(size_t)k * 6144]; const int kk = wave * 128 + k;
            a0 += scs[kk] * wv; a1 += scs[1024 + kk] * wv; a2 += scs[2048 + kk] * wv; a3 += scs[3072 + kk] * wv; }
        part[(wave * 4 + 0) * 64 + lane] = a0; part[(wave * 4 + 1) * 64 + lane] = a1; part[(wave * 4 + 2) * 64 + lane] = a2; part[(wave * 4 + 3) * 64 + lane] = a3;
        __syncthreads();
        if (wave < 4) { float s = b_ada[n];
#pragma unroll
            for (int w = 0; w < 8; ++w) s += part[(w * 4 + wave) * 64 + lane];
            ada[wave * 6144 + n] = s; }
        __syncthreads();
    }
    {
        LAS float* scr = (LAS float*)(lds + wave * 16384);
        constexpr int I_IN = 16 * (NIN / 32), I_SQ = 16 * 32, I_1 = 16 * (FF / 32), I_2 = (FF / 64) * 32;
        constexpr int NITEMS = I_IN + 3 * I_SQ + I_1 + I_2;
        for (int it = gw; it < NITEMS; it += NGW) {
            int r = it;
            if (r < I_IN) { p0_transpose_item(w_in, DM, NIN, Win_t, scr, r, lane); continue; } r -= I_IN;
            if (r < I_SQ) { p0_transpose_item(w_pa, DM, DM, Wpa_t, scr, r, lane); continue; } r -= I_SQ;
            if (r < I_SQ) { p0_transpose_item(w_pr, DM, DM, Wpr_t, scr, r, lane); continue; } r -= I_SQ;
            if (r < I_SQ) { p0_transpose_item(w_out, DM, DM, Wout_t, scr, r, lane); continue; } r -= I_SQ;
            if (r < I_1) { p0_transpose_item(w1, DM, FF, W1_t, scr, r, lane); continue; } r -= I_1;
            p0_transpose_item(w2, FF, DM, W2_t, scr, r, lane);
        }
        const float invf[8] = {1.0f, 0.1939227432012558f, 0.03760603070259094f, 0.007292664609849453f, 0.0014142135623842478f, 0.00027424818836152554f, 5.318296098266728e-05f, 1.0313386155758053e-05f};
        for (int row = bx * NTHR + tid; row < TT; row += G * NTHR) { const float pf = (float)args.pos[row];
#pragma unroll
            for (int i = 0; i < 8; ++i) { const float ang = pf * invf[i]; float sv, cv; sincosf(ang, &sv, &cv); rope[row * 16 + i] = cv; rope[row * 16 + 8 + i] = sv; } }
    }
    grid.sync();
    XcdBarrier xbar = xcd_barrier_post(barw, bst);
    { const int t1 = fresh_tid(), lane = t1 & 63, gw = vcu * NWAVES + (t1 >> 6);
    for (int m = gw; m < TT; m += NGW) { const int b = m >> 13;
        norm_mod_row(x + (size_t)m * DM, norm_mix, ada + b * 6144 + 1024, ada + b * 6144, XN + (size_t)m * DM, lane); } }
    xcd_barrier(xbar);

    for (int half = 0; half < 2; ++half) {
        { pg8::Gemm g{XN + (size_t)half * TH * DM, Win_t, TH, NIN, DM}; pg8::StaticOrder S; S.init(TH, NIN, G, bx);
          pg8::EpiInProj E{P, rope + (size_t)half * TH * 16};
          pg8::gemm_phase<pg8::EpiInProj, pg8::StaticOrder, true, true>(lds, g, S, E); }
        xcd_barrier(xbar);
        for (int cb = vcu; cb < 256; cb += G) {
            const int s = cb & 7, vb = cb >> 3;
            for (int i = 0; i < 4; ++i) {
                const int qb = (i == 0) ? s : (i == 1) ? 15 - s : (i == 2) ? 16 + s : 31 - s;
                const int b = vb >> 4, h = (vb >> 1) & 7, m = vb & 1;
                attn_body::attn_unit<8>(b, h * 2 + m, h * 2, qb, (const attn_body::bf16*)Pq, (const attn_body::bf16*)Pk, (const attn_body::bf16*)Pv,
                                        (attn_body::bf16*)(m ? O1 : O0), (char*)lds_raw);
            }
        }
        { const int t3 = fresh_tid();
          for (int u = vcu; u < 2048; u += G) { HgIn1 cur; hg_load1(cur, Prf, Pri, u, t3); hg_unit_state(lds, cur, lb_logits, Ust, dec, u, t3); } }
        xcd_barrier(xbar);
        for (int gid = vcu * NTHR + fresh_tid(); gid < 131072; gid += G * NTHR) {
            const int bh = gid >> 13, e2 = gid & 8191, k0 = (2 * e2) & 127;
            unsigned* up = (unsigned*)(Ust + (size_t)bh * 128 * 16384 + 2 * e2);
            const float* dp = dec + (size_t)bh * 128 * 128 + k0;
            float s0 = 0.f, s1 = 0.f;
            for (int c0 = 0; c0 < 128; c0 += 16) {
                unsigned uu[16]; float d0[16], d1[16];
#pragma unroll
                for (int i = 0; i < 16; ++i) { uu[i] = up[(size_t)(c0 + i) * 8192]; const float2 dd = *(const float2*)(dp + (c0 + i) * 128); d0[i] = dd.x; d1[i] = dd.y; }
#pragma unroll
                for (int i = 0; i < 16; ++i) { up[(size_t)(c0 + i) * 8192] = pk2(s0, s1); s0 = d0[i] * s0 + bflo(uu[i]); s1 = d1[i] * s1 + bfhi(uu[i]); }
            }
        }
        xcd_barrier(xbar);
        { const int t5 = fresh_tid();
          for (int u = vcu; u < 2048; u += G) { HgIn3 cur; hg_load3(cur, Prq, Prf, Pri, Prg, Ust, u, t5); hg_unit_out(lds, Prq, cur, Prg, Ust, lb_logits, rec_norm_w, u, t5); } }
        { const int t5c = fresh_tid(), lane = t5c & 63, gw = vcu * NWAVES + (t5c >> 6);
          float lam; { const float d1 = wave_sum(lam_q1[lane] * lam_k1[lane]), d2 = wave_sum(lam_q2[lane] * lam_k2[lane]); lam = __expf(d1) - __expf(d2) + 0.2f; }
        for (int m = gw; m < TH; m += NGW) {
            const v4u* a = (const v4u*)(O0 + (size_t)m * DM) + lane * 2; const v4u* b = (const v4u*)(O1 + (size_t)m * DM) + lane * 2;
            const v4u a0 = a[0], a1 = a[1], b0 = b[0], b1 = b[1];
            const unsigned aw[8] = {a0.x, a0.y, a0.z, a0.w, a1.x, a1.y, a1.z, a1.w}, bw[8] = {b0.x, b0.y, b0.z, b0.w, b1.x, b1.y, b1.z, b1.w};
            float o[16]; float ss = 0.f;
#pragma unroll
            for (int i = 0; i < 8; ++i) { o[2 * i] = bflo(aw[i]) - lam * bflo(bw[i]); o[2 * i + 1] = bfhi(aw[i]) - lam * bfhi(bw[i]); ss += o[2 * i] * o[2 * i] + o[2 * i + 1] * o[2 * i + 1]; }
            ss += __shfl_xor(ss, 1); ss += __shfl_xor(ss, 2); ss += __shfl_xor(ss, 4);
            const float rstd = 0.8f / sqrtf(ss * (1.f / 128.f) + EPS);
            const float* wp = subln_w + (lane & 7) * 16;
            unsigned ow[8];
#pragma unroll
            for (int i = 0; i < 8; ++i) ow[i] = pk2(o[2 * i] * rstd * wp[2 * i], o[2 * i + 1] * rstd * wp[2 * i + 1]);
            v4u* op = (v4u*)(Oa + (size_t)m * DM) + lane * 2;
            op[0] = (v4u){ow[0], ow[1], ow[2], ow[3]}; op[1] = (v4u){ow[4], ow[5], ow[6], ow[7]};
        } }
        xcd_barrier(xbar);
        { pg8::Gemm g{Oa, Wpa_t, TH, DM, DM}; pg8::StaticOrder S; S.init(TH, DM, G, bx);
          pg8::EpiGate1 E{Pga, Y1};
          pg8::gemm_phase<pg8::EpiGate1, pg8::StaticOrder, true, true>(lds, g, S, E); }
        { pg8::Gemm g{Prq, Wpr_t, TH, DM, DM}; pg8::StaticOrder S; S.init(TH, DM, G, bx);
          pg8::EpiGate2 E{Pgr, Y1, Y + (size_t)half * TH * DM};
          pg8::gemm_phase<pg8::EpiGate2, pg8::StaticOrder, true, true>(lds, g, S, E); }
        xcd_barrier(xbar);
    }
    { pg8::Gemm g{Y, Wout_t, TT, DM, DM}; pg8::StaticOrder S; S.init(TT, DM, G, bx);
      pg8::EpiRes E{x, args.out, ada + 2048};
      pg8::gemm_phase<pg8::EpiRes, pg8::StaticOrder, true, true>(lds, g, S, E); }
    xcd_barrier(xbar);
    { const int t8 = fresh_tid(), lane = t8 & 63, gw = vcu * NWAVES + (t8 >> 6);
    for (int m = gw; m < TT; m += NGW) { const int b = m >> 13;
        norm_mod_row(args.out + (size_t)m * DM, norm_mlp, ada + b * 6144 + 4096, ada + b * 6144 + 3072, XN + (size_t)m * DM, lane); } }
    xcd_barrier(xbar);
    { pg8::Gemm g{XN, W1_t, TT, FF, DM}; pg8::StaticOrder S; S.init(TT, FF, G, bx);
      pg8::EpiRelu2 E{UH, FF};
      pg8::gemm_phase<pg8::EpiRelu2, pg8::StaticOrder, true, true>(lds, g, S, E); }
    xcd_barrier(xbar);
    { pg8::Gemm g{UH, W2_t, TT, DM, FF}; pg8::StaticOrder S; S.init(TT, DM, G, bx);
      pg8::EpiRes E{args.out, args.out, ada + 5120};
      pg8::gemm_phase<pg8::EpiRes, pg8::StaticOrder, true, true>(lds, g, S, E); }
    xcd_barrier(xbar);
    { const int t11 = fresh_tid(), lane = t11 & 63, gw = vcu * NWAVES + (t11 >> 6);
    for (int m = gw; m < TT; m += NGW) {
        f32x4* xr = (f32x4*)(args.out + (size_t)m * DM) + lane;
        f32x4 v[4]; float s = 0.f;
#pragma unroll
        for (int j = 0; j < 4; ++j) { v[j] = xr[64 * j]; s += (v[j].x * v[j].x + v[j].y * v[j].y) + (v[j].z * v[j].z + v[j].w * v[j].w); }
        const float rinv = 1.0f / sqrtf(wave_sum(s) * (1.f / 1024.f) + EPS);
#pragma unroll
        for (int j = 0; j < 4; ++j) xr[64 * j] = v[j] * rinv * ((const f32x4*)norm_final)[lane + 64 * j];
    } }
}

extern "C" void kernel_launch(void* const* d_in, const int* in_sizes, int n_in, void* d_out, int out_size, void* d_ws, size_t ws_size, hipStream_t stream) {
    static int grid = 0;
    if (grid == 0) {
        if (n_in != 21 || in_sizes[0] != TT * DM || out_size != TT * DM || ws_size < WS_END) {
            fprintf(stderr, "kernel_launch: unexpected shapes: n_in %d in0 %d out %d ws %zu (need %zu)\n", n_in, n_in > 0 ? in_sizes[0] : -1, out_size, ws_size, (size_t)WS_END); grid = -1; return; }
        int dev = 0, cus = 0, per_cu = 0;
        hipGetDevice(&dev); hipDeviceGetAttribute(&cus, hipDeviceAttributeMultiprocessorCount, dev);
        if (hipFuncSetAttribute((const void*)fused_fwd, hipFuncAttributeMaxDynamicSharedMemorySize, LDS_BYTES) != hipSuccess) { fprintf(stderr, "kernel_launch: hipFuncSetAttribute failed\n"); grid = -1; return; }
        if (hipOccupancyMaxActiveBlocksPerMultiprocessor(&per_cu, (const void*)fused_fwd, NTHR, LDS_BYTES) != hipSuccess || per_cu < 1) { fprintf(stderr, "kernel_launch: occupancy query says %d\n", per_cu); per_cu = 1; }
        (void)hipGetLastError();
        grid = cus * 1;
        (void)per_cu;
    }
    if (grid < 0) return;
    Args a{};
    for (int i = 0; i < 21; ++i) a.in[i] = (const float*)d_in[i];
    a.pos = (const int*)d_in[2]; a.out = (float*)d_out; a.ws = (unsigned char*)d_ws;
    void* kargs[] = {&a};
    hipError_t e = hipLaunchCooperativeKernel((const void*)fused_fwd, dim3(grid), dim3(NTHR), kargs, LDS_BYTES, stream);
    if (e != hipSuccess) fprintf(stderr, "cooperative launch failed: %s (grid %d)\n", hipGetErrorString(e), grid);
}
```
